# Optimizing an MI355X kernel written in HIP

```python
import jax, jax.numpy as jnp
from jax import lax
import numpy as np

D_MODEL = 1024
BATCH = 16
SEQ = 2048
DEPTH = 1

PLE_DIM = 256
EPS = 1e-6
GM_WIDTH = 512
GM_GROUPS = 8
GM_CHUNK = 128
HG_HEADS = 4
HG_KEY = 128
HG_VAL = 128
HG_CHUNK = 64
HG_KW = HG_HEADS * HG_KEY
HG_VW = HG_HEADS * HG_VAL
IN_SPLITS = [GM_WIDTH, GM_WIDTH, HG_KW, HG_KW, HG_VW, HG_VW, D_MODEL, D_MODEL]
IN_COLS = sum(IN_SPLITS)
N_GROUPS = 4
EXP_PER_GROUP = 8
N_EXPERTS = N_GROUPS * EXP_PER_GROUP
TOP_K = 2
D_EXPERT = 512
MOE_BLOCK = 128

kernel_name = "hybrid_gmlp_hgrn2_hmoe_block"


def rmsnorm(x, g):
    xf = x.astype(jnp.float32)
    y = xf * lax.rsqrt(jnp.mean(xf * xf, axis=-1, keepdims=True) + EPS)
    return y.astype(x.dtype) * g


def layernorm(x, g, b):
    xf = x.astype(jnp.float32)
    mu = jnp.mean(xf, axis=-1, keepdims=True)
    var = jnp.mean(jnp.square(xf - mu), axis=-1, keepdims=True)
    y = (xf - mu) * lax.rsqrt(var + EPS)
    return y.astype(x.dtype) * g + b


def gmlp_branch(u, v, ln_g, ln_b, w_sp, b_sp):
    B, S, _ = u.shape
    n_c = S // GM_CHUNK
    dg = GM_WIDTH // GM_GROUPS
    v = layernorm(v, ln_g, ln_b).reshape(B, n_c, GM_CHUNK, GM_GROUPS, dg)
    mask = jnp.tril(jnp.ones((GM_CHUNK, GM_CHUNK), dtype=bool))
    w = jnp.where(mask[None], w_sp, jnp.zeros_like(w_sp))
    s = jnp.einsum('gts,bcsgd->bctgd', w, v) + b_sp.T[:, :, None]
    return u * s.reshape(B, S, GM_WIDTH)


def hgrn2_branch(q, f_raw, i_in, og, lb, norm_g):
    B, S, _ = q.shape
    C = HG_CHUNK
    n_c = S // C
    dt = q.dtype
    qf = jax.nn.silu(q.astype(jnp.float32)).reshape(B, n_c, C, HG_HEADS, HG_KEY)
    f = lb + (1.0 - lb) * jax.nn.sigmoid(f_raw.astype(jnp.float32))
    log_f = jnp.log(f).reshape(B, n_c, C, HG_HEADS, HG_KEY)
    k = (1.0 - f).reshape(B, n_c, C, HG_HEADS, HG_KEY)
    v = i_in.astype(jnp.float32).reshape(B, n_c, C, HG_HEADS, HG_VAL)
    b = jnp.cumsum(log_f, axis=2)
    b_last = b[:, :, -1:]
    q_dec = qf * jnp.exp(b)
    k_inv = k * jnp.exp(-b)
    k_end = k * jnp.exp(b_last - b)
    mask = jnp.tril(jnp.ones((C, C), dtype=bool))
    att = jnp.einsum('bcthk,bcshk->bchts', q_dec, k_inv)
    att = jnp.where(mask, att, jnp.zeros_like(att))
    o_intra = jnp.einsum('bchts,bcshv->bcthv', att, v)
    dS = jnp.einsum('bcshk,bcshv->bchkv', k_end, v)
    decay = jnp.exp(b_last[:, :, 0])

    def step(s_prev, inp):
        dec, ds = inp
        return dec[..., None] * s_prev + ds, s_prev

    s0 = jnp.zeros((B, HG_HEADS, HG_KEY, HG_VAL), jnp.float32)
    _, s_starts = lax.scan(step, s0, (jnp.moveaxis(decay, 1, 0), jnp.moveaxis(dS, 1, 0)))
    o_inter = jnp.einsum('bcthk,cbhkv->bcthv', q_dec, s_starts)
    o = (o_intra + o_inter).reshape(B, S, HG_HEADS, HG_VAL)
    o = o * lax.rsqrt(jnp.mean(o * o, axis=-1, keepdims=True) + EPS)
    o = o * norm_g.astype(jnp.float32).reshape(HG_HEADS, HG_VAL)
    return o.reshape(B, S, HG_VW).astype(dt) * jax.nn.sigmoid(og)


def hier_moe(h, w_grp, w_exp, w1, w3, w2):
    B, S, D = h.shape
    T = B * S
    xt = h.reshape(T, D)
    grp_logits = (xt @ w_grp).astype(jnp.float32)
    grp_prob = jax.nn.softmax(grp_logits, axis=-1)
    p_g, g_sel = lax.top_k(grp_prob, 1)
    exp_logits = (xt @ w_exp).astype(jnp.float32).reshape(T, N_GROUPS, EXP_PER_GROUP)
    sel_logits = jnp.take_along_axis(exp_logits, g_sel[:, :, None], axis=1)[:, 0]
    top_l, top_e = lax.top_k(sel_logits, TOP_K)
    gate = jax.nn.softmax(top_l, axis=-1) * p_g

    A = T * TOP_K
    eid = (g_sel * EXP_PER_GROUP + top_e).reshape(A)
    tok = jnp.repeat(jnp.arange(T, dtype=jnp.int32), TOP_K)
    wa = gate.reshape(A)
    order = jnp.argsort(eid)
    eid_s, tok_s, w_s = eid[order], tok[order], wa[order]
    counts = jnp.bincount(eid, length=N_EXPERTS)
    padded = ((counts + MOE_BLOCK - 1) // MOE_BLOCK) * MOE_BLOCK
    pad_end = jnp.cumsum(padded)
    pad_start = pad_end - padded
    start = jnp.cumsum(counts) - counts
    rank = jnp.arange(A, dtype=jnp.int32) - start[eid_s]
    dest = pad_start[eid_s] + rank
    n_blk = -(-A // MOE_BLOCK) + N_EXPERTS
    P = n_blk * MOE_BLOCK
    buf = jnp.zeros((P, D), xt.dtype).at[dest].set(xt[tok_s])
    blk_start = jnp.arange(n_blk, dtype=jnp.int32) * MOE_BLOCK
    blk_e = jnp.minimum(jnp.searchsorted(pad_end, blk_start, side='right'), N_EXPERTS - 1)

    def expert_block(args):
        xb, e = args
        return (jax.nn.silu(xb @ w1[e]) * (xb @ w3[e])) @ w2[e]

    ybuf = lax.map(expert_block, (buf.reshape(n_blk, MOE_BLOCK, D), blk_e)).reshape(P, D)
    contrib = ybuf[dest] * w_s[:, None].astype(xt.dtype)
    out = jax.ops.segment_sum(contrib, tok_s, num_segments=T)
    return out.reshape(B, S, D)


def setup_inputs(seed: int = 0) -> dict:
    key = jax.random.key(seed)
    ks = jax.random.split(key, 24)

    def nrm(k, shape, scale):
        return jax.random.normal(k, shape, jnp.float32) * scale

    def gain(k, shape):
        return 1.0 + 0.05 * jax.random.normal(k, shape, jnp.float32)

    L = DEPTH
    return {
        "x": nrm(ks[0], (BATCH, SEQ, D_MODEL), 1.0),
        "p": nrm(ks[1], (DEPTH, BATCH, SEQ, PLE_DIM), 1.0),
        "g_mix": gain(ks[2], (L, D_MODEL)),
        "w_in": nrm(ks[3], (L, D_MODEL, IN_COLS), D_MODEL ** -0.5),
        "gm_ln_g": gain(ks[4], (L, GM_WIDTH)),
        "gm_ln_b": nrm(ks[5], (L, GM_WIDTH), 0.02),
        "gm_w_sp": nrm(ks[6], (L, GM_GROUPS, GM_CHUNK, GM_CHUNK), 0.1 * GM_CHUNK ** -0.5),
        "gm_b_sp": gain(ks[7], (L, GM_GROUPS, GM_CHUNK)),
        "w_up_a": nrm(ks[8], (L, GM_WIDTH, D_MODEL), GM_WIDTH ** -0.5),
        "hg_lb_param": gain(ks[9], (L + 1, HG_KW)),
        "hg_norm_g": gain(ks[10], (L, HG_VW)),
        "w_up_b": nrm(ks[11], (L, HG_VW, D_MODEL), HG_VW ** -0.5),
        "w_out": nrm(ks[12], (L, D_MODEL, D_MODEL), D_MODEL ** -0.5),
        "g_ffn": gain(ks[13], (L, D_MODEL)),
        "w_grp": nrm(ks[14], (L, D_MODEL, N_GROUPS), D_MODEL ** -0.5),
        "w_exp": nrm(ks[15], (L, D_MODEL, N_EXPERTS), D_MODEL ** -0.5),
        "w1": nrm(ks[16], (L, N_EXPERTS, D_MODEL, D_EXPERT), D_MODEL ** -0.5),
        "w3": nrm(ks[17], (L, N_EXPERTS, D_MODEL, D_EXPERT), D_MODEL ** -0.5),
        "w2": nrm(ks[18], (L, N_EXPERTS, D_EXPERT, D_MODEL), D_EXPERT ** -0.5),
        "g_ple": gain(ks[19], (L, D_MODEL)),
        "w_pg": nrm(ks[20], (L, D_MODEL, D_MODEL), D_MODEL ** -0.5),
        "w_ple": nrm(ks[21], (L, PLE_DIM, D_MODEL), PLE_DIM ** -0.5),
        "g_final": gain(ks[22], (D_MODEL,)),
    }


def reference(x, p, g_mix, w_in, gm_ln_g, gm_ln_b, gm_w_sp, gm_b_sp, w_up_a,
              hg_lb_param, hg_norm_g, w_up_b, w_out, g_ffn, w_grp, w_exp,
              w1, w3, w2, g_ple, w_pg, w_ple, g_final):
    lb_all = jnp.cumsum(jax.nn.softmax(hg_lb_param.astype(jnp.float32), axis=0), axis=0)
    split_idx = [int(s) for s in np.cumsum(IN_SPLITS)[:-1]]
    for i in range(DEPTH):
        h = rmsnorm(x, g_mix[i])
        z = h @ w_in[i]
        u, v, hq, hf, hi, hog, gate_a, gate_b = jnp.split(z, split_idx, axis=-1)
        y_a = gmlp_branch(jax.nn.gelu(u), jax.nn.gelu(v), gm_ln_g[i], gm_ln_b[i], gm_w_sp[i], gm_b_sp[i])
        y_b = hgrn2_branch(hq, hf, hi, hog, lb_all[i], hg_norm_g[i])
        merged = jax.nn.sigmoid(gate_a) * (y_a @ w_up_a[i]) + jax.nn.sigmoid(gate_b) * (y_b @ w_up_b[i])
        x = x + merged @ w_out[i]
        h = rmsnorm(x, g_ffn[i])
        x = x + hier_moe(h, w_grp[i], w_exp[i], w1[i], w3[i], w2[i])
        h = rmsnorm(x, g_ple[i])
        x = x + jax.nn.sigmoid(h @ w_pg[i]) * (p[i] @ w_ple[i])
    return rmsnorm(x, g_final)
```

```cpp
#include <hip/hip_runtime.h>
#include <cstdio>
#include <cstdint>

typedef _Float16 h16;
constexpr int T = 32768, D = 1024, SEQ = 2048, NB = 16, INC = 5120, PLE = 256;
constexpr int NE = 32, DE = 512, NA = 2 * T, ECAP = T;
constexpr float EPS = 1e-6f;

constexpr size_t MiB = 1024 * 1024;
constexpr size_t WS_HB = 0;
constexpr size_t WS_Z = 64 * MiB;
constexpr size_t WS_UB = WS_Z;
constexpr size_t WS_VB = WS_Z + 32 * MiB;
constexpr size_t WS_QB = WS_Z + 64 * MiB;
constexpr size_t WS_FB = WS_Z + 96 * MiB;
constexpr size_t WS_IB = WS_Z + 128 * MiB;
constexpr size_t WS_OB = WS_Z + 160 * MiB;
constexpr size_t WS_GA = WS_Z + 192 * MiB;
constexpr size_t WS_GB = WS_Z + 256 * MiB;
constexpr size_t WS_H = WS_Z;
constexpr size_t WS_Y = WS_Z + 64 * MiB;
constexpr size_t WS_PL = WS_Z + 192 * MiB;
constexpr size_t WS_W = 384 * MiB;
constexpr size_t WS_MISC = 498 * MiB;
constexpr size_t WS_LIST = WS_MISC;
constexpr size_t WS_GATE = WS_MISC + 4 * MiB;
constexpr size_t WS_CNT = WS_MISC + 5 * MiB;
constexpr size_t WS_END = WS_MISC + 6 * MiB;

struct P {
    const float *x, *p, *g_mix, *w_in, *gm_ln_g, *gm_ln_b, *gm_w_sp, *gm_b_sp, *w_up_a, *hg_lb, *hg_norm_g, *w_up_b, *w_out, *g_ffn,
        *w_grp, *w_exp, *w1, *w3, *w2, *g_ple, *w_pg, *w_ple, *g_final;
    float* out; unsigned char* ws;
};

__device__ __forceinline__ float sigm(float v) { return 1.f / (1.f + expf(-v)); }
__device__ __forceinline__ float gelu_t(float v) { return v * sigm(1.5957691216057308f * (v + 0.044715f * v * v * v)); }
__device__ __forceinline__ float wave_sum(float v) {
#pragma unroll
    for (int o = 1; o < 64; o <<= 1) v += __shfl_xor(v, o);
    return v;
}

__global__ void n_rmsnorm(const float* x, const float* g, h16* out) {
    int row = blockIdx.x * 4 + (threadIdx.x >> 6), lane = threadIdx.x & 63;
    const float* xr = x + (size_t)row * D; float v[16]; float s = 0.f;
    for (int j = 0; j < 16; ++j) { v[j] = xr[lane + 64 * j]; s += v[j] * v[j]; }
    float r = rsqrtf(wave_sum(s) * (1.f / D) + EPS);
    for (int j = 0; j < 16; ++j) out[(size_t)row * D + lane + 64 * j] = (h16)(v[j] * r * g[lane + 64 * j]);
}

template <int DUAL, class F>
__global__ void __launch_bounds__(256) ngemm(int N, int K, F f) {
    __shared__ float As[DUAL + 1][16][65], Bs[DUAL + 1][16][65];
    const int M = f.rows(); const int r0 = blockIdx.y * 64, c0 = blockIdx.x * 64;
    if (r0 >= M) return;
    const int tx = threadIdx.x & 15, ty = threadIdx.x >> 4;
    float acc[DUAL + 1][4][4] = {};
    for (int k0 = 0; k0 < K; k0 += 16) {
        for (int w = 0; w <= DUAL; ++w)
            for (int i = threadIdx.x; i < 1024; i += 256) {
                int r = i >> 4, kk = i & 15; As[w][kk][r] = (r0 + r < M) ? f.fa(r0 + r, k0 + kk, w) : 0.f;
                int kb = i >> 6, c = i & 63; Bs[w][kb][c] = f.fb(k0 + kb, c0 + c, w);
            }
        __syncthreads();
        for (int w = 0; w <= DUAL; ++w)
#pragma unroll
            for (int kk = 0; kk < 16; ++kk) {
                float a[4], b[4];
#pragma unroll
                for (int i = 0; i < 4; ++i) { a[i] = As[w][kk][ty * 4 + i]; b[i] = Bs[w][kk][tx * 4 + i]; }
#pragma unroll
                for (int i = 0; i < 4; ++i)
#pragma unroll
                    for (int j = 0; j < 4; ++j) acc[w][i][j] += a[i] * b[j];
            }
        __syncthreads();
    }
    for (int i = 0; i < 4; ++i) for (int j = 0; j < 4; ++j) { int r = r0 + ty * 4 + i, c = c0 + tx * 4 + j; if (r < M) f.fe(r, c, acc[0][i][j], acc[DUAL][i][j]); }
}

struct F_in {
    P p;
    __device__ int rows() const { return T; }
    __device__ float fa(int r, int k, int) const { return (float)((const h16*)(p.ws + WS_HB))[(size_t)r * D + k]; }
    __device__ float fb(int k, int c, int) const { return p.w_in[(size_t)k * INC + c]; }
    __device__ void fe(int r, int c, float a, float) const {
        unsigned char* ws = p.ws; int part = c >> 9;
        if (part == 0) ((h16*)(ws + WS_UB))[(size_t)r * 512 + c] = (h16)gelu_t(a);
        else if (part == 1) ((h16*)(ws + WS_VB))[(size_t)r * 512 + c - 512] = (h16)gelu_t(a);
        else if (part == 2) ((h16*)(ws + WS_QB))[(size_t)r * 512 + c - 1024] = (h16)(a * sigm(a));
        else if (part == 3) { int j = c - 1536; float lb = 1.f / (1.f + expf(p.hg_lb[512 + j] - p.hg_lb[j])); float fv = lb + (1.f - lb) * sigm(a);
            ((h16*)(ws + WS_FB))[(size_t)r * 512 + j] = (h16)logf(fv); }
        else if (part == 4) ((h16*)(ws + WS_IB))[(size_t)r * 512 + c - 2048] = (h16)a;
        else if (part == 5) ((h16*)(ws + WS_OB))[(size_t)r * 512 + c - 2560] = (h16)a;
        else if (part < 8) ((h16*)(ws + WS_GA))[(size_t)r * D + c - 3072] = (h16)sigm(a);
        else ((h16*)(ws + WS_GB))[(size_t)r * D + c - 4096] = (h16)sigm(a);
    }
};

__global__ void n_lnv(P p) {
    int row = blockIdx.x * 4 + (threadIdx.x >> 6), lane = threadIdx.x & 63;
    h16* vr = (h16*)(p.ws + WS_VB) + (size_t)row * 512; float v[8]; float s = 0.f;
    for (int j = 0; j < 8; ++j) { v[j] = (float)vr[lane + 64 * j]; s += v[j]; }
    float mu = wave_sum(s) * (1.f / 512); float q = 0.f;
    for (int j = 0; j < 8; ++j) { v[j] -= mu; q += v[j] * v[j]; }
    float r = rsqrtf(wave_sum(q) * (1.f / 512) + EPS);
    for (int j = 0; j < 8; ++j) { int c = lane + 64 * j; vr[c] = (h16)(v[j] * r * p.gm_ln_g[c] + p.gm_ln_b[c]); }
}
__global__ void __launch_bounds__(256) n_gmlp(P p) {
    __shared__ float vs[128][65];
    const int tile = blockIdx.x, g = blockIdx.y; const size_t t0 = (size_t)tile * 128;
    const h16* vb = (const h16*)(p.ws + WS_VB); h16* ub = (h16*)(p.ws + WS_UB);
    for (int i = threadIdx.x; i < 128 * 64; i += 256) { int s = i >> 6, d = i & 63; vs[s][d] = (float)vb[(t0 + s) * 512 + g * 64 + d]; }
    __syncthreads();
    for (int i = threadIdx.x; i < 128 * 64; i += 256) { int t = i >> 6, d = i & 63; float acc = 0.f;
        const float* w = p.gm_w_sp + ((size_t)g * 128 + t) * 128;
        for (int s = 0; s <= t; ++s) acc += w[s] * vs[s][d];
        acc += p.gm_b_sp[g * 128 + t];
        size_t o = (t0 + t) * 512 + g * 64 + d; ub[o] = (h16)((float)ub[o] * acc); }
}
__global__ void __launch_bounds__(128) n_hgrn(P p) {
    __shared__ float fk[128], kk[128], qk[128];
    const int b = blockIdx.x >> 2, h = blockIdx.x & 3, v = threadIdx.x;
    const h16* qb = (const h16*)(p.ws + WS_QB); const h16* fb = (const h16*)(p.ws + WS_FB); h16* ib = (h16*)(p.ws + WS_IB);
    float S[128];
#pragma unroll
    for (int k = 0; k < 128; ++k) S[k] = 0.f;
    for (int t = 0; t < SEQ; ++t) {
        size_t o = ((size_t)b * SEQ + t) * 512 + h * 128 + v;
        float f = expf((float)fb[o]); fk[v] = f; kk[v] = 1.f - f; qk[v] = (float)qb[o]; float iv = (float)ib[o];
        __syncthreads();
        float acc = 0.f;
#pragma unroll
        for (int k = 0; k < 128; ++k) { S[k] = fk[k] * S[k] + kk[k] * iv; acc += S[k] * qk[k]; }
        __syncthreads();
        ib[o] = (h16)acc;
    }
}
__global__ void n_hgfin(P p) {
    int row = blockIdx.x * 4 + (threadIdx.x >> 6), lane = threadIdx.x & 63;
    const h16* ob = (const h16*)(p.ws + WS_IB) + (size_t)row * 512; const h16* og = (const h16*)(p.ws + WS_OB) + (size_t)row * 512; h16* yb = (h16*)(p.ws + WS_QB) + (size_t)row * 512;
    int c0 = (lane >> 4) * 128 + (lane & 15) * 8; float v[8]; float s = 0.f;
    for (int j = 0; j < 8; ++j) { v[j] = (float)ob[c0 + j]; s += v[j] * v[j]; }
    for (int o = 1; o < 16; o <<= 1) s += __shfl_xor(s, o);
    float r = rsqrtf(s * (1.f / 128) + EPS);
    for (int j = 0; j < 8; ++j) yb[c0 + j] = (h16)(v[j] * r * p.hg_norm_g[c0 + j] * sigm((float)og[c0 + j]));
}
struct F_up {
    P p;
    __device__ int rows() const { return T; }
    __device__ float fa(int r, int k, int w) const { return (float)((const h16*)(p.ws + (w ? WS_QB : WS_UB)))[(size_t)r * 512 + k]; }
    __device__ float fb(int k, int c, int w) const { return (w ? p.w_up_b : p.w_up_a)[(size_t)k * D + c]; }
    __device__ void fe(int r, int c, float a0, float a1) const { h16* ga = (h16*)(p.ws + WS_GA); const h16* gb = (const h16*)(p.ws + WS_GB); size_t o = (size_t)r * D + c;
        ga[o] = (h16)((float)ga[o] * a0 + (float)gb[o] * a1); }
};
struct F_out {
    P p;
    __device__ int rows() const { return T; }
    __device__ float fa(int r, int k, int) const { return (float)((const h16*)(p.ws + WS_GA))[(size_t)r * D + k]; }
    __device__ float fb(int k, int c, int) const { return p.w_out[(size_t)k * D + c]; }
    __device__ void fe(int r, int c, float a, float) const { size_t o = (size_t)r * D + c; p.out[o] = p.x[o] + a; }
};
__global__ void n_route(P p) {
    int row = blockIdx.x * 4 + (threadIdx.x >> 6), lane = threadIdx.x & 63;
    const float* xr = p.out + (size_t)row * D; float v[16]; float s = 0.f;
    for (int j = 0; j < 16; ++j) { v[j] = xr[lane + 64 * j]; s += v[j] * v[j]; }
    float r = rsqrtf(wave_sum(s) * (1.f / D) + EPS);
    h16* hb = (h16*)(p.ws + WS_HB) + (size_t)row * D;
    for (int j = 0; j < 16; ++j) { v[j] = v[j] * r * p.g_ffn[lane + 64 * j]; hb[lane + 64 * j] = (h16)v[j]; }
    __shared__ float lgs[4][40]; float* lg = lgs[threadIdx.x >> 6]; float* le = lg + 4;
    for (int n = 0; n < 4; ++n) { float a = 0.f; for (int j = 0; j < 16; ++j) a += v[j] * p.w_grp[(size_t)(lane + 64 * j) * 4 + n]; a = wave_sum(a); if (lane == 0) lg[n] = a; }
    for (int n = 0; n < 32; ++n) { float a = 0.f; for (int j = 0; j < 16; ++j) a += v[j] * p.w_exp[(size_t)(lane + 64 * j) * 32 + n]; a = wave_sum(a); if (lane == 0) le[n] = a; }
    if (lane == 0) {
        int gs = 0; for (int n = 1; n < 4; ++n) if (lg[n] > lg[gs]) gs = n;
        float den = 0.f; for (int n = 0; n < 4; ++n) den += expf(lg[n] - lg[gs]); float pg = 1.f / den;
        int e0 = 0; for (int n = 1; n < 8; ++n) if (le[gs * 8 + n] > le[gs * 8 + e0]) e0 = n;
        int e1 = (e0 == 0) ? 1 : 0; for (int n = 0; n < 8; ++n) if (n != e0 && le[gs * 8 + n] > le[gs * 8 + e1]) e1 = n;
        float l0 = le[gs * 8 + e0], l1 = le[gs * 8 + e1]; float w1 = expf(l1 - l0); float g0 = pg / (1.f + w1), g1 = pg * w1 / (1.f + w1);
        int* cnt = (int*)(p.ws + WS_CNT); int* list = (int*)(p.ws + WS_LIST); float* gate = (float*)(p.ws + WS_GATE);
        int E0 = gs * 8 + e0, E1 = gs * 8 + e1;
        int p0 = atomicAdd(&cnt[E0], 1); list[(size_t)E0 * ECAP + p0] = 2 * row; gate[2 * row] = g0;
        int p1 = atomicAdd(&cnt[E1], 1); list[(size_t)E1 * ECAP + p1] = 2 * row + 1; gate[2 * row + 1] = g1;
    }
}
struct F_mup {
    P p;
    __device__ int rows() const { return ((const int*)(p.ws + WS_CNT))[blockIdx.z]; }
    __device__ float fa(int r, int k, int) const { int a = ((const int*)(p.ws + WS_LIST))[(size_t)blockIdx.z * ECAP + r]; return (float)((const h16*)(p.ws + WS_HB))[(size_t)(a >> 1) * D + k]; }
    __device__ float fb(int k, int c, int w) const { return (w ? p.w3 : p.w1)[((size_t)blockIdx.z * D + k) * DE + c]; }
    __device__ void fe(int r, int c, float a0, float a1) const { int a = ((const int*)(p.ws + WS_LIST))[(size_t)blockIdx.z * ECAP + r];
        ((h16*)(p.ws + WS_H))[(size_t)a * DE + c] = (h16)(a0 * sigm(a0) * a1); }
};
struct F_mdn {
    P p;
    __device__ int rows() const { return ((const int*)(p.ws + WS_CNT))[blockIdx.z]; }
    __device__ float fa(int r, int k, int) const { int a = ((const int*)(p.ws + WS_LIST))[(size_t)blockIdx.z * ECAP + r]; return (float)((const h16*)(p.ws + WS_H))[(size_t)a * DE + k]; }
    __device__ float fb(int k, int c, int) const { return p.w2[((size_t)blockIdx.z * DE + k) * D + c]; }
    __device__ void fe(int r, int c, float a0, float) const { int a = ((const int*)(p.ws + WS_LIST))[(size_t)blockIdx.z * ECAP + r];
        ((h16*)(p.ws + WS_Y))[(size_t)a * D + c] = (h16)(a0 * ((const float*)(p.ws + WS_GATE))[a]); }
};
__global__ void n_combine(P p) {
    int row = blockIdx.x * 4 + (threadIdx.x >> 6), lane = threadIdx.x & 63;
    float* xr = p.out + (size_t)row * D; const h16* y0 = (const h16*)(p.ws + WS_Y) + (size_t)(2 * row) * D; float v[16]; float s = 0.f;
    for (int j = 0; j < 16; ++j) { int c = lane + 64 * j; v[j] = xr[c] + (float)y0[c] + (float)y0[D + c]; xr[c] = v[j]; s += v[j] * v[j]; }
    float r = rsqrtf(wave_sum(s) * (1.f / D) + EPS);
    h16* hb = (h16*)(p.ws + WS_HB) + (size_t)row * D;
    for (int j = 0; j < 16; ++j) hb[lane + 64 * j] = (h16)(v[j] * r * p.g_ple[lane + 64 * j]);
}
struct F_ple {
    P p;
    __device__ int rows() const { return T; }
    __device__ float fa(int r, int k, int) const { return p.p[(size_t)r * PLE + k]; }
    __device__ float fb(int k, int c, int) const { return p.w_ple[(size_t)k * D + c]; }
    __device__ void fe(int r, int c, float a, float) const { ((h16*)(p.ws + WS_PL))[(size_t)r * D + c] = (h16)a; }
};
struct F_pg {
    P p;
    __device__ int rows() const { return T; }
    __device__ float fa(int r, int k, int) const { return (float)((const h16*)(p.ws + WS_HB))[(size_t)r * D + k]; }
    __device__ float fb(int k, int c, int) const { return p.w_pg[(size_t)k * D + c]; }
    __device__ void fe(int r, int c, float a, float) const { size_t o = (size_t)r * D + c; p.out[o] = p.out[o] + sigm(a) * (float)((const h16*)(p.ws + WS_PL))[o]; }
};
__global__ void n_final(P p) {
    int row = blockIdx.x * 4 + (threadIdx.x >> 6), lane = threadIdx.x & 63;
    float* xr = p.out + (size_t)row * D; float v[16]; float s = 0.f;
    for (int j = 0; j < 16; ++j) { v[j] = xr[lane + 64 * j]; s += v[j] * v[j]; }
    float r = rsqrtf(wave_sum(s) * (1.f / D) + EPS);
    for (int j = 0; j < 16; ++j) xr[lane + 64 * j] = v[j] * r * p.g_final[lane + 64 * j];
}

extern "C" void kernel_launch(void* const* d_in, const int* in_sizes, int n_in, void* d_out, int out_size, void* d_ws, size_t ws_size, hipStream_t stream) {
    if (n_in != 23 || ws_size < WS_END) { fprintf(stderr, "kernel_launch: unexpected n_in %d / ws_size %zu\n", n_in, ws_size); return; }
    P p{};
    const float** f = (const float**)&p;
    for (int i = 0; i < 23; ++i) f[i] = (const float*)d_in[i];
    p.out = (float*)d_out; p.ws = (unsigned char*)d_ws;
    hipMemsetAsync((char*)d_ws + WS_CNT, 0, 4096, stream);
    n_rmsnorm<<<T / 4, 256, 0, stream>>>(p.x, p.g_mix, (h16*)(p.ws + WS_HB));
    ngemm<0, F_in><<<dim3(INC / 64, T / 64), 256, 0, stream>>>(INC, D, F_in{p});
    n_lnv<<<T / 4, 256, 0, stream>>>(p);
    n_gmlp<<<dim3(T / 128, 8), 256, 0, stream>>>(p);
    n_hgrn<<<64, 128, 0, stream>>>(p);
    n_hgfin<<<T / 4, 256, 0, stream>>>(p);
    ngemm<1, F_up><<<dim3(D / 64, T / 64), 256, 0, stream>>>(D, 512, F_up{p});
    ngemm<0, F_out><<<dim3(D / 64, T / 64), 256, 0, stream>>>(D, D, F_out{p});
    n_route<<<T / 4, 256, 0, stream>>>(p);
    ngemm<1, F_mup><<<dim3(DE / 64, ECAP / 64, NE), 256, 0, stream>>>(DE, D, F_mup{p});
    ngemm<0, F_mdn><<<dim3(D / 64, ECAP / 64, NE), 256, 0, stream>>>(D, DE, F_mdn{p});
    n_combine<<<T / 4, 256, 0, stream>>>(p);
    ngemm<0, F_ple><<<dim3(D / 64, T / 64), 256, 0, stream>>>(D, PLE, F_ple{p});
    ngemm<0, F_pg><<<dim3(D / 64, T / 64), 256, 0, stream>>>(D, D, F_pg{p});
    n_final<<<T / 4, 256, 0, stream>>>(p);
}
```

```cpp
#include <hip/hip_runtime.h>
#include <cstdio>
#include <cstdint>

typedef _Float16 h16;
constexpr int T = 32768, D = 1024, SEQ = 2048, NB = 16, INC = 5120, PLE = 256;
constexpr int NE = 32, DE = 512, NA = 2 * T, ECAP = T;
constexpr float EPS = 1e-6f;

constexpr size_t MiB = 1024 * 1024;
constexpr size_t WS_HB = 0;
constexpr size_t WS_Z = 64 * MiB;
constexpr size_t WS_UB = WS_Z;
constexpr size_t WS_VB = WS_Z + 32 * MiB;
constexpr size_t WS_QB = WS_Z + 64 * MiB;
constexpr size_t WS_FB = WS_Z + 96 * MiB;
constexpr size_t WS_IB = WS_Z + 128 * MiB;
constexpr size_t WS_OB = WS_Z + 160 * MiB;
constexpr size_t WS_GA = WS_Z + 192 * MiB;
constexpr size_t WS_GB = WS_Z + 256 * MiB;
constexpr size_t WS_H = WS_Z;
constexpr size_t WS_Y = WS_Z + 64 * MiB;
constexpr size_t WS_PL = WS_Z + 192 * MiB;
constexpr size_t WS_W = 384 * MiB;
constexpr size_t WS_MISC = 498 * MiB;
constexpr size_t WS_LIST = WS_MISC;
constexpr size_t WS_GATE = WS_MISC + 4 * MiB;
constexpr size_t WS_CNT = WS_MISC + 5 * MiB;
constexpr size_t WS_END = WS_MISC + 6 * MiB;

struct P {
    const float *x, *p, *g_mix, *w_in, *gm_ln_g, *gm_ln_b, *gm_w_sp, *gm_b_sp, *w_up_a, *hg_lb, *hg_norm_g, *w_up_b, *w_out, *g_ffn,
        *w_grp, *w_exp, *w1, *w3, *w2, *g_ple, *w_pg, *w_ple, *g_final;
    float* out; unsigned char* ws;
};

__device__ __forceinline__ float sigm(float v) { return 1.f / (1.f + expf(-v)); }
__device__ __forceinline__ float gelu_t(float v) { return v * sigm(1.5957691216057308f * (v + 0.044715f * v * v * v)); }
__device__ __forceinline__ float wave_sum(float v) {
#pragma unroll
    for (int o = 1; o < 64; o <<= 1) v += __shfl_xor(v, o);
    return v;
}

__global__ void n_rmsnorm(const float* x, const float* g, h16* out) {
    int row = blockIdx.x * 4 + (threadIdx.x >> 6), lane = threadIdx.x & 63;
    const float* xr = x + (size_t)row * D; float v[16]; float s = 0.f;
    for (int j = 0; j < 16; ++j) { v[j] = xr[lane + 64 * j]; s += v[j] * v[j]; }
    float r = rsqrtf(wave_sum(s) * (1.f / D) + EPS);
    for (int j = 0; j < 16; ++j) out[(size_t)row * D + lane + 64 * j] = (h16)(v[j] * r * g[lane + 64 * j]);
}

template <int DUAL, class F>
__global__ void __launch_bounds__(256) ngemm(int N, int K, F f) {
    __shared__ float As[DUAL + 1][16][65], Bs[DUAL + 1][16][65];
    const int M = f.rows(); const int r0 = blockIdx.y * 64, c0 = blockIdx.x * 64;
    if (r0 >= M) return;
    const int tx = threadIdx.x & 15, ty = threadIdx.x >> 4;
    float acc[DUAL + 1][4][4] = {};
    for (int k0 = 0; k0 < K; k0 += 16) {
        for (int w = 0; w <= DUAL; ++w)
            for (int i = threadIdx.x; i < 1024; i += 256) {
                int r = i >> 4, kk = i & 15; As[w][kk][r] = (r0 + r < M) ? f.fa(r0 + r, k0 + kk, w) : 0.f;
                int kb = i >> 6, c = i & 63; Bs[w][kb][c] = f.fb(k0 + kb, c0 + c, w);
            }
        __syncthreads();
        for (int w = 0; w <= DUAL; ++w)
#pragma unroll
            for (int kk = 0; kk < 16; ++kk) {
                float a[4], b[4];
#pragma unroll
                for (int i = 0; i < 4; ++i) { a[i] = As[w][kk][ty * 4 + i]; b[i] = Bs[w][kk][tx * 4 + i]; }
#pragma unroll
                for (int i = 0; i < 4; ++i)
#pragma unroll
                    for (int j = 0; j < 4; ++j) acc[w][i][j] += a[i] * b[j];
            }
        __syncthreads();
    }
    for (int i = 0; i < 4; ++i) for (int j = 0; j < 4; ++j) { int r = r0 + ty * 4 + i, c = c0 + tx * 4 + j; if (r < M) f.fe(r, c, acc[0][i][j], acc[DUAL][i][j]); }
}

struct F_in {
    P p;
    __device__ int rows() const { return T; }
    __device__ float fa(int r, int k, int) const { return (float)((const h16*)(p.ws + WS_HB))[(size_t)r * D + k]; }
    __device__ float fb(int k, int c, int) const { return p.w_in[(size_t)k * INC + c]; }
    __device__ void fe(int r, int c, float a, float) const {
        unsigned char* ws = p.ws; int part = c >> 9;
        if (part == 0) ((h16*)(ws + WS_UB))[(size_t)r * 512 + c] = (h16)gelu_t(a);
        else if (part == 1) ((h16*)(ws + WS_VB))[(size_t)r * 512 + c - 512] = (h16)gelu_t(a);
        else if (part == 2) ((h16*)(ws + WS_QB))[(size_t)r * 512 + c - 1024] = (h16)(a * sigm(a));
        else if (part == 3) { int j = c - 1536; float lb = 1.f / (1.f + expf(p.hg_lb[512 + j] - p.hg_lb[j])); float fv = lb + (1.f - lb) * sigm(a);
            ((h16*)(ws + WS_FB))[(size_t)r * 512 + j] = (h16)logf(fv); }
        else if (part == 4) ((h16*)(ws + WS_IB))[(size_t)r * 512 + c - 2048] = (h16)a;
        else if (part == 5) ((h16*)(ws + WS_OB))[(size_t)r * 512 + c - 2560] = (h16)a;
        else if (part < 8) ((h16*)(ws + WS_GA))[(size_t)r * D + c - 3072] = (h16)sigm(a);
        else ((h16*)(ws + WS_GB))[(size_t)r * D + c - 4096] = (h16)sigm(a);
    }
};

__global__ void n_lnv(P p) {
    int row = blockIdx.x * 4 + (threadIdx.x >> 6), lane = threadIdx.x & 63;
    h16* vr = (h16*)(p.ws + WS_VB) + (size_t)row * 512; float v[8]; float s = 0.f;
    for (int j = 0; j < 8; ++j) { v[j] = (float)vr[lane + 64 * j]; s += v[j]; }
    float mu = wave_sum(s) * (1.f / 512); float q = 0.f;
    for (int j = 0; j < 8; ++j) { v[j] -= mu; q += v[j] * v[j]; }
    float r = rsqrtf(wave_sum(q) * (1.f / 512) + EPS);
    for (int j = 0; j < 8; ++j) { int c = lane + 64 * j; vr[c] = (h16)(v[j] * r * p.gm_ln_g[c] + p.gm_ln_b[c]); }
}
__global__ void __launch_bounds__(256) n_gmlp(P p) {
    __shared__ float vs[128][65];
    const int tile = blockIdx.x, g = blockIdx.y; const size_t t0 = (size_t)tile * 128;
    const h16* vb = (const h16*)(p.ws + WS_VB); h16* ub = (h16*)(p.ws + WS_UB);
    for (int i = threadIdx.x; i < 128 * 64; i += 256) { int s = i >> 6, d = i & 63; vs[s][d] = (float)vb[(t0 + s) * 512 + g * 64 + d]; }
    __syncthreads();
    for (int i = threadIdx.x; i < 128 * 64; i += 256) { int t = i >> 6, d = i & 63; float acc = 0.f;
        const float* w = p.gm_w_sp + ((size_t)g * 128 + t) * 128;
        for (int s = 0; s <= t; ++s) acc += w[s] * vs[s][d];
        acc += p.gm_b_sp[g * 128 + t];
        size_t o = (t0 + t) * 512 + g * 64 + d; ub[o] = (h16)((float)ub[o] * acc); }
}
__global__ void __launch_bounds__(128) n_hgrn(P p) {
    __shared__ float fk[128], kk[128], qk[128];
    const int b = blockIdx.x >> 2, h = blockIdx.x & 3, v = threadIdx.x;
    const h16* qb = (const h16*)(p.ws + WS_QB); const h16* fb = (const h16*)(p.ws + WS_FB); h16* ib = (h16*)(p.ws + WS_IB);
    float S[128];
#pragma unroll
    for (int k = 0; k < 128; ++k) S[k] = 0.f;
    for (int t = 0; t < SEQ; ++t) {
        size_t o = ((size_t)b * SEQ + t) * 512 + h * 128 + v;
        float f = expf((float)fb[o]); fk[v] = f; kk[v] = 1.f - f; qk[v] = (float)qb[o]; float iv = (float)ib[o];
        __syncthreads();
        float acc = 0.f;
#pragma unroll
        for (int k = 0; k < 128; ++k) { S[k] = fk[k] * S[k] + kk[k] * iv; acc += S[k] * qk[k]; }
        __syncthreads();
        ib[o] = (h16)acc;
    }
}
__global__ void n_hgfin(P p) {
    int row = blockIdx.x * 4 + (threadIdx.x >> 6), lane = threadIdx.x & 63;
    const h16* ob = (const h16*)(p.ws + WS_IB) + (size_t)row * 512; const h16* og = (const h16*)(p.ws + WS_OB) + (size_t)row * 512; h16* yb = (h16*)(p.ws + WS_QB) + (size_t)row * 512;
    int c0 = (lane >> 4) * 128 + (lane & 15) * 8; float v[8]; float s = 0.f;
    for (int j = 0; j < 8; ++j) { v[j] = (float)ob[c0 + j]; s += v[j] * v[j]; }
    for (int o = 1; o < 16; o <<= 1) s += __shfl_xor(s, o);
    float r = rsqrtf(s * (1.f / 128) + EPS);
    for (int j = 0; j < 8; ++j) yb[c0 + j] = (h16)(v[j] * r * p.hg_norm_g[c0 + j] * sigm((float)og[c0 + j]));
}
struct F_up {
    P p;
    __device__ int rows() const { return T; }
    __device__ float fa(int r, int k, int w) const { return (float)((const h16*)(p.ws + (w ? WS_QB : WS_UB)))[(size_t)r * 512 + k]; }
    __device__ float fb(int k, int c, int w) const { return (w ? p.w_up_b : p.w_up_a)[(size_t)k * D + c]; }
    __device__ void fe(int r, int c, float a0, float a1) const { h16* ga = (h16*)(p.ws + WS_GA); const h16* gb = (const h16*)(p.ws + WS_GB); size_t o = (size_t)r * D + c;
        ga[o] = (h16)((float)ga[o] * a0 + (float)gb[o] * a1); }
};
struct F_out {
    P p;
    __device__ int rows() const { return T; }
    __device__ float fa(int r, int k, int) const { return (float)((const h16*)(p.ws + WS_GA))[(size_t)r * D + k]; }
    __device__ float fb(int k, int c, int) const { return p.w_out[(size_t)k * D + c]; }
    __device__ void fe(int r, int c, float a, float) const { size_t o = (size_t)r * D + c; p.out[o] = p.x[o] + a; }
};
__global__ void n_route(P p) {
    int row = blockIdx.x * 4 + (threadIdx.x >> 6), lane = threadIdx.x & 63;
    const float* xr = p.out + (size_t)row * D; float v[16]; float s = 0.f;
    for (int j = 0; j < 16; ++j) { v[j] = xr[lane + 64 * j]; s += v[j] * v[j]; }
    float r = rsqrtf(wave_sum(s) * (1.f / D) + EPS);
    h16* hb = (h16*)(p.ws + WS_HB) + (size_t)row * D;
    for (int j = 0; j < 16; ++j) { v[j] = v[j] * r * p.g_ffn[lane + 64 * j]; hb[lane + 64 * j] = (h16)v[j]; }
    __shared__ float lgs[4][40]; float* lg = lgs[threadIdx.x >> 6]; float* le = lg + 4;
    for (int n = 0; n < 4; ++n) { float a = 0.f; for (int j = 0; j < 16; ++j) a += v[j] * p.w_grp[(size_t)(lane + 64 * j) * 4 + n]; a = wave_sum(a); if (lane == 0) lg[n] = a; }
    for (int n = 0; n < 32; ++n) { float a = 0.f; for (int j = 0; j < 16; ++j) a += v[j] * p.w_exp[(size_t)(lane + 64 * j) * 32 + n]; a = wave_sum(a); if (lane == 0) le[n] = a; }
    if (lane == 0) {
        int gs = 0; for (int n = 1; n < 4; ++n) if (lg[n] > lg[gs]) gs = n;
        float den = 0.f; for (int n = 0; n < 4; ++n) den += expf(lg[n] - lg[gs]); float pg = 1.f / den;
        int e0 = 0; for (int n = 1; n < 8; ++n) if (le[gs * 8 + n] > le[gs * 8 + e0]) e0 = n;
        int e1 = (e0 == 0) ? 1 : 0; for (int n = 0; n < 8; ++n) if (n != e0 && le[gs * 8 + n] > le[gs * 8 + e1]) e1 = n;
        float l0 = le[gs * 8 + e0], l1 = le[gs * 8 + e1]; float w1 = expf(l1 - l0); float g0 = pg / (1.f + w1), g1 = pg * w1 / (1.f + w1);
        int* cnt = (int*)(p.ws + WS_CNT); int* list = (int*)(p.ws + WS_LIST); float* gate = (float*)(p.ws + WS_GATE);
        int E0 = gs * 8 + e0, E1 = gs * 8 + e1;
        int p0 = atomicAdd(&cnt[E0], 1); list[(size_t)E0 * ECAP + p0] = 2 * row; gate[2 * row] = g0;
        int p1 = atomicAdd(&cnt[E1], 1); list[(size_t)E1 * ECAP + p1] = 2 * row + 1; gate[2 * row + 1] = g1;
    }
}
struct F_mup {
    P p;
    __device__ int rows() const { return ((const int*)(p.ws + WS_CNT))[blockIdx.z]; }
    __device__ float fa(int r, int k, int) const { int a = ((const int*)(p.ws + WS_LIST))[(size_t)blockIdx.z * ECAP + r]; return (float)((const h16*)(p.ws + WS_HB))[(size_t)(a >> 1) * D + k]; }
    __device__ float fb(int k, int c, int w) const { return (w ? p.w3 : p.w1)[((size_t)blockIdx.z * D + k) * DE + c]; }
    __device__ void fe(int r, int c, float a0, float a1) const { int a = ((const int*)(p.ws + WS_LIST))[(size_t)blockIdx.z * ECAP + r];
        ((h16*)(p.ws + WS_H))[(size_t)a * DE + c] = (h16)(a0 * sigm(a0) * a1); }
};
struct F_mdn {
    P p;
    __device__ int rows() const { return ((const int*)(p.ws + WS_CNT))[blockIdx.z]; }
    __device__ float fa(int r, int k, int) const { int a = ((const int*)(p.ws + WS_LIST))[(size_t)blockIdx.z * ECAP + r]; return (float)((const h16*)(p.ws + WS_H))[(size_t)a * DE + k]; }
    __device__ float fb(int k, int c, int) const { return p.w2[((size_t)blockIdx.z * DE + k) * D + c]; }
    __device__ void fe(int r, int c, float a0, float) const { int a = ((const int*)(p.ws + WS_LIST))[(size_t)blockIdx.z * ECAP + r];
        ((h16*)(p.ws + WS_Y))[(size_t)a * D + c] = (h16)(a0 * ((const float*)(p.ws + WS_GATE))[a]); }
};
__global__ void n_combine(P p) {
    int row = blockIdx.x * 4 + (threadIdx.x >> 6), lane = threadIdx.x & 63;
    float* xr = p.out + (size_t)row * D; const h16* y0 = (const h16*)(p.ws + WS_Y) + (size_t)(2 * row) * D; float v[16]; float s = 0.f;
    for (int j = 0; j < 16; ++j) { int c = lane + 64 * j; v[j] = xr[c] + (float)y0[c] + (float)y0[D + c]; xr[c] = v[j]; s += v[j] * v[j]; }
    float r = rsqrtf(wave_sum(s) * (1.f / D) + EPS);
    h16* hb = (h16*)(p.ws + WS_HB) + (size_t)row * D;
    for (int j = 0; j < 16; ++j) hb[lane + 64 * j] = (h16)(v[j] * r * p.g_ple[lane + 64 * j]);
}
struct F_ple {
    P p;
    __device__ int rows() const { return T; }
    __device__ float fa(int r, int k, int) const { return p.p[(size_t)r * PLE + k]; }
    __device__ float fb(int k, int c, int) const { return p.w_ple[(size_t)k * D + c]; }
    __device__ void fe(int r, int c, float a, float) const { ((h16*)(p.ws + WS_PL))[(size_t)r * D + c] = (h16)a; }
};
struct F_pg {
    P p;
    __device__ int rows() const { return T; }
    __device__ float fa(int r, int k, int) const { return (float)((const h16*)(p.ws + WS_HB))[(size_t)r * D + k]; }
    __device__ float fb(int k, int c, int) const { return p.w_pg[(size_t)k * D + c]; }
    __device__ void fe(int r, int c, float a, float) const { size_t o = (size_t)r * D + c; p.out[o] = p.out[o] + sigm(a) * (float)((const h16*)(p.ws + WS_PL))[o]; }
};
__global__ void n_final(P p) {
    int row = blockIdx.x * 4 + (threadIdx.x >> 6), lane = threadIdx.x & 63;
    float* xr = p.out + (size_t)row * D; float v[16]; float s = 0.f;
    for (int j = 0; j < 16; ++j) { v[j] = xr[lane + 64 * j]; s += v[j] * v[j]; }
    float r = rsqrtf(wave_sum(s) * (1.f / D) + EPS);
    for (int j = 0; j < 16; ++j) xr[lane + 64 * j] = v[j] * r * p.g_final[lane + 64 * j];
}


#define LAS __attribute__((address_space(3)))
typedef _Float16 h16x8 __attribute__((ext_vector_type(8)));
typedef _Float16 h16x4 __attribute__((ext_vector_type(4)));
typedef _Float16 h16x2 __attribute__((ext_vector_type(2)));
typedef float f32x4 __attribute__((ext_vector_type(4)));
typedef float f32x2 __attribute__((ext_vector_type(2)));
typedef unsigned u32x4 __attribute__((ext_vector_type(4)));
typedef unsigned u32x2 __attribute__((ext_vector_type(2)));

constexpr size_t WS_WIN = WS_W;
constexpr size_t WS_W13 = WS_W + 10 * MiB;
constexpr size_t WS_W2 = WS_W + 74 * MiB;
constexpr size_t WS_WPG = WS_W + 106 * MiB;
constexpr size_t WS_WOUT = WS_W + 108 * MiB;
constexpr size_t WS_WUA = WS_W + 110 * MiB;
constexpr size_t WS_WUB = WS_W + 111 * MiB;
constexpr size_t WS_WPLE = WS_W + 112 * MiB;
constexpr size_t WS_WSP = WS_W + 112 * MiB + 512 * 1024;
constexpr size_t WS_WR = WS_W + 112 * MiB + 768 * 1024;
constexpr size_t WS_LB = WS_W + 112 * MiB + 896 * 1024;
constexpr size_t WS_P16 = WS_Z + 256 * MiB;
constexpr size_t WS_CTL = WS_MISC + 5 * MiB + 4096;
static_assert(WS_LB + 2048 <= WS_MISC, "weight map");

__device__ __forceinline__ float fsig(float v) { return __builtin_amdgcn_rcpf(1.f + __builtin_amdgcn_exp2f(-1.4426950408889634f * v)); }
__device__ __forceinline__ float fgelu(float v) { return v * fsig(1.5957691216057308f * (v + 0.044715f * v * v * v)); }
__device__ __forceinline__ unsigned pkh(float a, float b) { h16x2 t; t.x = (h16)a; t.y = (h16)b; return __builtin_bit_cast(unsigned, t); }
__device__ __forceinline__ u32x4 pk8(f32x4 a, f32x4 b) { u32x4 w; w.x = pkh(a[0], a[1]); w.y = pkh(a[2], a[3]); w.z = pkh(b[0], b[1]); w.w = pkh(b[2], b[3]); return w; }
__device__ __forceinline__ void unpk8(u32x4 w, f32x4& a, f32x4& b) {
    const h16x8 t = __builtin_bit_cast(h16x8, w);
    a = (f32x4){(float)t[0], (float)t[1], (float)t[2], (float)t[3]}; b = (f32x4){(float)t[4], (float)t[5], (float)t[6], (float)t[7]}; }

namespace g8 {
constexpr int BM = 256, BK = 64, HALF = 128, HTB = HALF * BK * 2, STAGE_BYTES = 8 * HTB, NXCD = 8, WGM = 8;
__device__ __forceinline__ int lds_byte(int r, int c) { const int st = (r >> 4) * 2 + (c >> 5), rr = r & 15, cc = c & 31, ob = rr * 64 + cc * 2; return st * 1024 + (ob ^ (((ob >> 9) & 1) << 5)); }
__device__ __forceinline__ void stage_rc(int b, int& R, int& C) { const int st = b / 1024, sb = b % 1024, swz = sb ^ (((sb >> 9) & 1) << 5); R = (st >> 1) * 16 + swz / 64; C = (st & 1) * 32 + (swz % 64) / 2; }
__device__ __forceinline__ int perm32(int rho) { const int n = rho >> 4, i = rho & 15; return 8 * (i >> 2) + 4 * n + (i & 3); }
struct Tile { int pm, pn; };
struct StaticOrder {
    int nM, nN, nwg, G, c;
    __device__ void init(int nM_, int nN_, int G_, int c_) { nM = nM_; nN = nN_; nwg = nM * nN; G = G_; c = c_; }
    __device__ bool next(int i, Tile& u) const {
        const long L = (long)i * G + c; if (L >= nwg) return false;
        int wgid = (int)L; { const int q = nwg / NXCD, r = nwg % NXCD, xcd = wgid % NXCD, off = wgid / NXCD; wgid = (xcd < r ? xcd * (q + 1) : r * (q + 1) + (xcd - r) * q) + off; }
        const int nig = WGM * nN, gid = wgid / nig, fm = gid * WGM, gsz = (nM - fm) < WGM ? (nM - fm) : WGM;
        u.pm = fm + ((wgid % nig) % gsz); u.pn = (wgid % nig) / gsz; return true;
    }
};
template <class PH>
__device__ __forceinline__ void gemm_phase(LAS unsigned char* lds, const PH& ph) {
    const int tid = threadIdx.x, wid = __builtin_amdgcn_readfirstlane(tid >> 6), lane = tid & 63, wr = wid >> 2, wc = wid & 3, fr = lane & 15, fq = lane >> 4;
    constexpr int nt = PH::KT;
    int R[2], C[2]; unsigned voffB[2], voffA[2];
#pragma unroll
    for (int i = 0; i < 2; ++i) { stage_rc(tid * 16 + i * 8192, R[i], C[i]); const int Rb = PH::PERM ? ((R[i] & ~31) + perm32(R[i] & 31)) : R[i]; voffB[i] = (unsigned)(Rb * PH::LDB + C[i] * 2); voffA[i] = (unsigned)(R[i] * PH::LDA + C[i] * 2); }
    constexpr size_t kstep = BK * 2, hstepB = (size_t)HALF * PH::LDB, hstepA = PH::GATHER ? 0 : (size_t)HALF * PH::LDA;
    const unsigned ldsw = (unsigned)wid * 1024u;
    const int aoff = lds_byte(wr * 64 + fr, fq * 8), boff = lds_byte(wc * 32 + fr, fq * 8);
#define G8_SA(b, h) (((b) * 2 + (h)) * HTB)
#define G8_SB(b, h) ((4 + (b) * 2 + (h)) * HTB)
#define G8_STG(bufoff, gptr, o0, o1) do { \
        __builtin_amdgcn_global_load_lds((const unsigned*)((gptr) + (o0)), (LAS unsigned*)(lds + (bufoff) + ldsw), 16, 0, 0); \
        __builtin_amdgcn_global_load_lds((const unsigned*)((gptr) + (o1)), (LAS unsigned*)(lds + (bufoff) + ldsw + 8192), 16, 0, 0); } while (0)
#define G8_STGB(bufoff, gptr) G8_STG(bufoff, gptr, voffB[0], voffB[1])
#define G8_STGA(bufoff, gptr, h, useN) do { if constexpr (PH::GATHER) { G8_STG(bufoff, gptr, ((useN) ? na[h][0] : ca[h][0]), ((useN) ? na[h][1] : ca[h][1])); } \
        else { G8_STG(bufoff, (gptr) + (h) * hstepA, voffA[0], voffA[1]); } } while (0)
#define G8_LDA(dst, b, h) do { _Pragma("unroll") for (int m = 0; m < 4; ++m) _Pragma("unroll") for (int k = 0; k < 2; ++k) dst[m][k] = *(const LAS h16x8*)(lds + G8_SA(b, h) + aoff + m * 2048 + k * 1024); } while (0)
#define G8_LDB(dst, b, h) do { _Pragma("unroll") for (int n = 0; n < 2; ++n) _Pragma("unroll") for (int k = 0; k < 2; ++k) dst[n][k] = *(const LAS h16x8*)(lds + G8_SB(b, h) + boff + n * 2048 + k * 1024); } while (0)
#define G8_MMA(ai, bj, At, Bt) do { __builtin_amdgcn_s_setprio(1); _Pragma("unroll") for (int m = 0; m < 4; ++m) _Pragma("unroll") for (int n = 0; n < 2; ++n) _Pragma("unroll") for (int k = 0; k < 2; ++k) \
        acc[ai][bj][m][n] = __builtin_amdgcn_mfma_f32_16x16x32_f16(Bt[n][k], At[m][k], acc[ai][bj][m][n], 0, 0, 0); __builtin_amdgcn_s_setprio(0); } while (0)
#define G8_WAIT_V(n) asm volatile("s_waitcnt vmcnt(" #n ")" ::: "memory")
#define G8_WAIT_L(n) asm volatile("s_waitcnt lgkmcnt(" #n ")" ::: "memory")
#define G8_BAR __builtin_amdgcn_s_barrier()
#define G8_SCHED __builtin_amdgcn_sched_barrier(0)
    typename PH::Unit cur, nxt; int ui = 0;
    if (!ph.next(0, cur)) return;
    f32x4 acc[2][2][4][2];
#pragma unroll
    for (int a = 0; a < 2; ++a)
#pragma unroll
        for (int b = 0; b < 2; ++b)
#pragma unroll
            for (int m = 0; m < 4; ++m)
#pragma unroll
                for (int n = 0; n < 2; ++n) acc[a][b][m][n] = (f32x4){0.f, 0.f, 0.f, 0.f};
    h16x8 At[4][2], B0[2][2], B1[2][2];
    unsigned ca[2][2], na[2][2];
    if constexpr (PH::GATHER) ph.a_off(cur, R, C, ca);
    const char* cA = ph.a_ptr(cur); const char* cB = ph.b_ptr(cur);
    G8_STGB(G8_SB(0, 0), cB); G8_STGB(G8_SB(0, 1), cB + hstepB); G8_STGA(G8_SA(0, 0), cA, 0, false); G8_STGA(G8_SA(0, 1), cA, 1, false);
    if (wr == 1) G8_BAR;
    G8_WAIT_V(2); G8_BAR;
    G8_STGB(G8_SB(1, 0), cB + kstep); G8_STGA(G8_SA(1, 0), cA + kstep, 0, false); G8_STGB(G8_SB(1, 1), cB + hstepB + kstep);
    G8_WAIT_V(6); G8_BAR;
    for (;;) {
        const bool has_next = ph.next(ui + 1, nxt);
        const char* nA; const char* nB;
        if (has_next) { if constexpr (PH::GATHER) ph.a_off(nxt, R, C, na); nA = ph.a_ptr(nxt); nB = ph.b_ptr(nxt); }
        else { if constexpr (PH::GATHER) { na[0][0] = ca[0][0]; na[0][1] = ca[0][1]; na[1][0] = ca[1][0]; na[1][1] = ca[1][1]; } nA = cA; nB = cB; }
#pragma unroll 1
        for (int t = 0; t < nt; t += 2) {
            const bool last = (t == nt - 2);
            const char* a1 = cA + (size_t)(t + 1) * kstep;
            const char* a2 = last ? nA : cA + (size_t)(t + 2) * kstep; const char* b2 = last ? nB : cB + (size_t)(t + 2) * kstep;
            const char* a3 = a2 + kstep; const char* b3 = b2 + kstep;
            G8_LDB(B0, 0, 0); G8_LDB(B1, 0, 1); G8_SCHED; G8_LDA(At, 0, 0); G8_STGA(G8_SA(1, 1), a1, 1, false);
            G8_WAIT_V(8); G8_WAIT_L(0); G8_BAR; G8_MMA(0, 0, At, B0); G8_MMA(0, 1, At, B1); G8_BAR; G8_SCHED;
            G8_LDA(At, 0, 1); G8_STGB(G8_SB(0, 0), b2); G8_STGB(G8_SB(0, 1), b2 + hstepB); G8_STGA(G8_SA(0, 0), a2, 0, last);
            G8_WAIT_V(8); G8_WAIT_L(0); G8_BAR; G8_MMA(1, 0, At, B0); G8_MMA(1, 1, At, B1); G8_BAR; G8_SCHED;
            G8_LDB(B0, 1, 0); G8_LDB(B1, 1, 1); G8_SCHED; G8_LDA(At, 1, 0); G8_STGA(G8_SA(0, 1), a2, 1, last);
            G8_WAIT_V(8); G8_WAIT_L(0); G8_BAR; G8_MMA(0, 0, At, B0); G8_MMA(0, 1, At, B1); G8_BAR; G8_SCHED;
            G8_LDA(At, 1, 1); G8_STGB(G8_SB(1, 0), b3); G8_STGB(G8_SB(1, 1), b3 + hstepB); G8_STGA(G8_SA(1, 0), a3, 0, last);
            G8_WAIT_V(8); G8_WAIT_L(0); G8_BAR; G8_MMA(1, 0, At, B0); G8_MMA(1, 1, At, B1); G8_BAR; G8_SCHED;
        }
        if (wr == 0) G8_BAR;
        const bool keep = ph.epi(acc, cur, wr, wc, fr, fq);
        if (!has_next) break;
        if (!keep) {
#pragma unroll
            for (int a = 0; a < 2; ++a)
#pragma unroll
                for (int b = 0; b < 2; ++b)
#pragma unroll
                    for (int m = 0; m < 4; ++m)
#pragma unroll
                        for (int n = 0; n < 2; ++n) acc[a][b][m][n] = (f32x4){0.f, 0.f, 0.f, 0.f};
        }
        cur = nxt; cA = nA; cB = nB; if constexpr (PH::GATHER) { ca[0][0] = na[0][0]; ca[0][1] = na[0][1]; ca[1][0] = na[1][0]; ca[1][1] = na[1][1]; } ++ui;
        if (wr == 1) G8_BAR;
    }
    G8_WAIT_V(0);
    G8_BAR;
#undef G8_SA
#undef G8_SB
#undef G8_STG
#undef G8_STGB
#undef G8_STGA
#undef G8_LDA
#undef G8_LDB
#undef G8_MMA
#undef G8_WAIT_V
#undef G8_WAIT_L
#undef G8_BAR
#undef G8_SCHED
}
}

#define XB_TMO      128
#define XB_XCNT(j)  (256  + 64 * (j))
#define XB_XSUB(j)  (1280 + 64 * (j))
#define XB_XGEN(j)  (2304 + 64 * (j))
#define XB_TOP      3328
#define XB_TOPGEN   3392
#define XCD_BAR_WORDS 3456
#define XB_SPIN_CAP (1u << 18)
__device__ __forceinline__ unsigned xb_ld(unsigned* p)              { return __hip_atomic_load(p, __ATOMIC_RELAXED, __HIP_MEMORY_SCOPE_AGENT); }
__device__ __forceinline__ unsigned xb_add(unsigned* p, unsigned v) { return __hip_atomic_fetch_add(p, v, __ATOMIC_RELAXED, __HIP_MEMORY_SCOPE_AGENT); }
__device__ __forceinline__ unsigned xb_xcc_id() { return (unsigned)__builtin_amdgcn_s_getreg((3 << 11) | 20) & 0xFu; }
#define XB_SPIN(cond, bar) do { unsigned _sp = 0; while (cond) { __builtin_amdgcn_s_sleep(1); \
    if ((++_sp & 255u) == 0u) { if (xb_ld(&(bar)[XB_TMO])) break; if (_sp > XB_SPIN_CAP) { atomicAdd(&(bar)[XB_TMO], 1u); break; } } } } while (0)
struct XcdBarrier { unsigned* bar; unsigned x; volatile LAS unsigned* st; };
__device__ __forceinline__ XcdBarrier xcd_barrier_post(unsigned* bar, volatile LAS unsigned* st) {
    XcdBarrier b; b.bar = bar; b.x = xb_xcc_id(); b.st = st;
    if (threadIdx.x == 0) (void)xb_add(&bar[XB_XCNT(b.x)], 1u);
    return b;
}
__device__ __forceinline__ void xcd_barrier_complete(unsigned* bar, unsigned x, unsigned& nloc, unsigned& nx) {
    const unsigned G = gridDim.x * gridDim.y * gridDim.z;
    unsigned sum, cnt, mine, sp = 0u;
    for (;;) {
        sum = 0u; cnt = 0u; mine = 0u;
#pragma unroll
        for (unsigned j = 0; j < 16; ++j) { const unsigned c = xb_ld(&bar[XB_XCNT(j)]); sum += c; cnt += (c > 0u) ? 1u : 0u; mine = (j == x) ? c : mine; }
        if (sum == G) break;
        __builtin_amdgcn_s_sleep(1);
        if ((++sp & 255u) == 0u) { if (xb_ld(&bar[XB_TMO])) break; if (sp > XB_SPIN_CAP) { atomicAdd(&bar[XB_TMO], 1u); break; } }
    }
    nloc = mine > 0u ? mine : 1u; nx = cnt > 0u ? cnt : 1u;
}
__device__ __forceinline__ void xcd_barrier(const XcdBarrier& b) {
    asm volatile("s_waitcnt vmcnt(0)" ::: "memory");
    __syncthreads();
    if (threadIdx.x == 0) {
        unsigned* bar = b.bar;
        __builtin_amdgcn_s_waitcnt(0);
        unsigned nloc = b.st[0], nx = b.st[1];
        if (nloc == 0u) { xcd_barrier_complete(bar, b.x, nloc, nx); b.st[0] = nloc; b.st[1] = nx; }
        const unsigned old = xb_add(&bar[XB_XSUB(b.x)], 1u);
        const unsigned gen = old / nloc;
        if (old + 1u == (gen + 1u) * nloc) {
            __builtin_amdgcn_fence(__ATOMIC_RELEASE, "agent");
            asm volatile("s_waitcnt vmcnt(0)" ::: "memory");
            const unsigned og = xb_add(&bar[XB_TOP], 1u);
            const unsigned tg = og / nx;
            if (og + 1u == (tg + 1u) * nx) xb_add(&bar[XB_TOPGEN], 1u);
            else XB_SPIN(xb_ld(&bar[XB_TOPGEN]) == tg, bar);
            __builtin_amdgcn_fence(__ATOMIC_ACQUIRE, "agent");
            xb_add(&bar[XB_XGEN(b.x)], 1u);
            asm volatile("s_waitcnt vmcnt(0)" ::: "memory");
        } else {
            XB_SPIN(xb_ld(&bar[XB_XGEN(b.x)]) == gen, bar);
            __builtin_amdgcn_fence(__ATOMIC_ACQUIRE, "agent");
            asm volatile("s_waitcnt vmcnt(0)" ::: "memory");
        }
    }
    __syncthreads();
}

constexpr int RING_BYTES = 131072;
constexpr int LDS_BYTES = 147456;
constexpr int MISC_OFF = LDS_BYTES - 128;
constexpr int NWAVES = 8;

struct Frame { LAS unsigned char* lds; int tid, lane, wave, G, vcu; P p; };

__device__ __forceinline__ void p0_item(const float* W, int ldw, h16* WT, int ldt, int drow0, int k0, int n0, LAS float* scr, int lane) {
#pragma unroll 8
    for (int i = 0; i < 32; ++i) { const int kk = 2 * i + (lane >> 5); scr[kk * 33 + (lane & 31)] = W[(size_t)(k0 + kk) * ldw + n0 + (lane & 31)]; }
    asm volatile("s_waitcnt lgkmcnt(0)" ::: "memory");
    const int c = lane & 7;
#pragma unroll
    for (int j = 0; j < 4; ++j) { const int n = (lane >> 3) + 8 * j; const LAS float* s = scr + (8 * c) * 33 + n;
        u32x4 o; o.x = pkh(s[0 * 33], s[1 * 33]); o.y = pkh(s[2 * 33], s[3 * 33]); o.z = pkh(s[4 * 33], s[5 * 33]); o.w = pkh(s[6 * 33], s[7 * 33]);
        *(u32x4*)(WT + (size_t)(drow0 + n) * ldt + k0 + 8 * c) = o; }
    asm volatile("s_waitcnt lgkmcnt(0)" ::: "memory");
}
__device__ __forceinline__ void rms_row_h16(const float* xrow, const float* g, h16* orow, int lane) {
    const f32x4* xr = (const f32x4*)xrow + lane; f32x4 v[4]; float s = 0.f;
#pragma unroll
    for (int j = 0; j < 4; ++j) { v[j] = xr[64 * j]; s += (v[j].x * v[j].x + v[j].y * v[j].y) + (v[j].z * v[j].z + v[j].w * v[j].w); }
    const float r = rsqrtf(wave_sum(s) * (1.f / D) + EPS);
    u32x2* o8 = (u32x2*)orow + lane;
#pragma unroll
    for (int j = 0; j < 4; ++j) { const f32x4 gg = ((const f32x4*)g)[lane + 64 * j]; u32x2 w; w.x = pkh(v[j].x * r * gg.x, v[j].y * r * gg.y); w.y = pkh(v[j].z * r * gg.z, v[j].w * r * gg.w); o8[64 * j] = w; }
}
__device__ __forceinline__ void p0_prologue(Frame& F) {
    const P& p = F.p; unsigned char* ws = p.ws;
    LAS float* scr = (LAS float*)(F.lds + F.wave * 16384);
    const int gw = F.vcu * NWAVES + F.wave, NGW = F.G * NWAVES;
    constexpr int I_IN = 16 * 160, I_UA = 8 * 32, I_OUT = 16 * 32, I_PLE = 4 * 32, I_E13 = 16 * 16, I_E2 = 8 * 32;
    constexpr int NITEMS = I_IN + 2 * I_UA + 2 * I_OUT + I_PLE + NE * (2 * I_E13 + I_E2);
    for (int it = gw; it < NITEMS; it += NGW) {
        int r = it;
        if (r < I_IN) { const int kb = r / 160, nb = r % 160; p0_item(p.w_in, INC, (h16*)(ws + WS_WIN), D, nb * 32, kb * 64, nb * 32, scr, F.lane); continue; } r -= I_IN;
        if (r < I_UA) { const int kb = r / 32, nb = r % 32; p0_item(p.w_up_a, D, (h16*)(ws + WS_WUA), 512, nb * 32, kb * 64, nb * 32, scr, F.lane); continue; } r -= I_UA;
        if (r < I_UA) { const int kb = r / 32, nb = r % 32; p0_item(p.w_up_b, D, (h16*)(ws + WS_WUB), 512, nb * 32, kb * 64, nb * 32, scr, F.lane); continue; } r -= I_UA;
        if (r < I_OUT) { const int kb = r / 32, nb = r % 32; p0_item(p.w_out, D, (h16*)(ws + WS_WOUT), D, nb * 32, kb * 64, nb * 32, scr, F.lane); continue; } r -= I_OUT;
        if (r < I_OUT) { const int kb = r / 32, nb = r % 32; p0_item(p.w_pg, D, (h16*)(ws + WS_WPG), D, nb * 32, kb * 64, nb * 32, scr, F.lane); continue; } r -= I_OUT;
        if (r < I_PLE) { const int kb = r / 32, nb = r % 32; p0_item(p.w_ple, D, (h16*)(ws + WS_WPLE), PLE, nb * 32, kb * 64, nb * 32, scr, F.lane); continue; } r -= I_PLE;
        const int e = r / (2 * I_E13 + I_E2); r -= e * (2 * I_E13 + I_E2);
        if (r < 2 * I_E13) { const int which = r / I_E13; r -= which * I_E13; const int kb = r / 16, nb = r % 16, n0 = nb * 32;
            const int drow = (n0 >> 7) * 256 + which * 128 + (n0 & 127);
            p0_item((which ? p.w3 : p.w1) + (size_t)e * D * DE, DE, (h16*)(ws + WS_W13) + (size_t)e * D * D, D, drow, kb * 64, n0, scr, F.lane); continue; }
        r -= 2 * I_E13;
        { const int kb = r / 32, nb = r % 32; p0_item(p.w2 + (size_t)e * DE * D, D, (h16*)(ws + WS_W2) + (size_t)e * D * DE, DE, nb * 32, kb * 64, nb * 32, scr, F.lane); }
    }
    const int gt = F.vcu * 512 + F.tid, NGT = F.G * 512;
    for (int i = gt; i < 48 * 1024; i += NGT) { const int n = i >> 10, k = i & 1023; float v = 0.f;
        if (n < 4) v = p.w_grp[k * 4 + n] * p.g_ffn[k]; else if (n < 36) v = p.w_exp[k * 32 + (n - 4)] * p.g_ffn[k];
        ((h16*)(ws + WS_WR))[i] = (h16)v; }
    for (int i = gt; i < 8 * 128 * 128; i += NGT) { const int t = (i >> 7) & 127, s = i & 127; ((h16*)(ws + WS_WSP))[i] = (h16)(s <= t ? p.gm_w_sp[i] : 0.f); }
    for (int i = gt; i < 512; i += NGT) ((float*)(ws + WS_LB))[i] = 1.f / (1.f + expf(p.hg_lb[512 + i] - p.hg_lb[i]));
    for (int m = gw; m < T; m += NGW) rms_row_h16(p.x + (size_t)m * D, p.g_mix, (h16*)(ws + WS_HB) + (size_t)m * D, F.lane);
}

struct PhIn {
    static constexpr int KT = 16, LDA = 2048, LDB = 2048; static constexpr bool PERM = true, GATHER = false;
    using Unit = g8::Tile;
    g8::StaticOrder S; unsigned char* ws;
    __device__ __forceinline__ bool next(int i, Unit& u) const { return S.next(i, u); }
    __device__ __forceinline__ const char* a_ptr(const Unit& u) const { return (const char*)(ws + WS_HB) + (size_t)u.pm * 256 * LDA; }
    __device__ __forceinline__ const char* b_ptr(const Unit& u) const { return (const char*)(ws + WS_WIN) + (size_t)u.pn * 256 * LDB; }
    __device__ __forceinline__ void a_off(const Unit&, const int (&)[2], const int (&)[2], unsigned (&)[2][2]) const {}
    template <int MODE> __device__ __forceinline__ void store_tile(const f32x4 (&acc)[2][2][4][2], h16* base, int ld, int row0, int col0, int lbc0) const {
        f32x4 l0[2], l1[2];
        if (MODE == 2) {
#pragma unroll
            for (int bj = 0; bj < 2; ++bj) { l0[bj] = *(const f32x4*)((const float*)(ws + WS_LB) + lbc0 + bj * 128); l1[bj] = *(const f32x4*)((const float*)(ws + WS_LB) + lbc0 + bj * 128 + 4); }
        }
#pragma unroll
        for (int ai = 0; ai < 2; ++ai)
#pragma unroll
            for (int m = 0; m < 4; ++m) { h16* rowp = base + (size_t)(row0 + ai * 128 + m * 16) * ld + col0;
#pragma unroll
                for (int bj = 0; bj < 2; ++bj) { f32x4 v0 = acc[ai][bj][m][0], v1 = acc[ai][bj][m][1];
#pragma unroll
                    for (int j = 0; j < 4; ++j) {
                        if (MODE == 0) { v0[j] = fgelu(v0[j]); v1[j] = fgelu(v1[j]); }
                        if (MODE == 1) { v0[j] = v0[j] * fsig(v0[j]); v1[j] = v1[j] * fsig(v1[j]); }
                        if (MODE == 2) { const float a = l0[bj][j], b = l1[bj][j];
                            v0[j] = 0.6931471805599453f * __builtin_amdgcn_logf(a + (1.f - a) * fsig(v0[j])); v1[j] = 0.6931471805599453f * __builtin_amdgcn_logf(b + (1.f - b) * fsig(v1[j])); }
                        if (MODE == 4) { v0[j] = fsig(v0[j]); v1[j] = fsig(v1[j]); }
                    }
                    *(u32x4*)(rowp + bj * 128) = pk8(v0, v1); } }
    }
    __device__ __forceinline__ bool epi(const f32x4 (&acc)[2][2][4][2], const Unit& u, int wr, int wc, int fr, int fq) const {
        const int pn = u.pn, row0 = u.pm * 256 + wr * 64 + fr, cl = wc * 32 + 8 * fq;
        if (pn < 12) { h16* base = (h16*)(ws + WS_UB + (size_t)(pn >> 1) * 32 * MiB); const int col0 = (pn & 1) * 256 + cl;
            if (pn < 4) store_tile<0>(acc, base, 512, row0, col0, 0);
            else if (pn < 6) store_tile<1>(acc, base, 512, row0, col0, 0);
            else if (pn < 8) store_tile<2>(acc, base, 512, row0, col0, col0);
            else store_tile<3>(acc, base, 512, row0, col0, 0);
        } else { h16* base = (h16*)(ws + (pn < 16 ? WS_GA : WS_GB)); store_tile<4>(acc, base, 1024, row0, ((pn - 12) & 3) * 256 + cl, 0); }
        return false;
    }
};

constexpr int WRS = 2064;
constexpr int RT_SCR = 100352;
__device__ __forceinline__ void route_phase(Frame& F) {
    const P& p = F.p; unsigned char* ws = p.ws; const int lane = F.lane, fr = lane & 15, fq = lane >> 4;
    for (int i = F.tid; i < 48 * 128; i += 512) { const int n = i >> 7, c = i & 127; *(LAS u32x4*)(F.lds + n * WRS + c * 16) = *(const u32x4*)(ws + WS_WR + (size_t)n * 2048 + c * 16); }
    LAS float* scr = (LAS float*)(F.lds + RT_SCR + F.wave * 3200);
    LAS int* hist = (LAS int*)(F.lds + RT_SCR + 8 * 3200);
    for (int tile = F.vcu * 8 + F.wave; tile < T / 16; tile += F.G * 8) {
        if (F.tid < 64) hist[F.tid] = 0;
        __syncthreads();
        const int row = tile * 16 + fr;
        const float* xr = p.out + (size_t)row * D + fq * 8;
        h16x8 af[32]; float ss = 0.f; f32x4 acc[3] = {{0.f, 0.f, 0.f, 0.f}, {0.f, 0.f, 0.f, 0.f}, {0.f, 0.f, 0.f, 0.f}};
#pragma unroll
        for (int ks = 0; ks < 32; ++ks) {
            const f32x4 v0 = *(const f32x4*)(xr + ks * 32), v1 = *(const f32x4*)(xr + ks * 32 + 4);
            ss += (v0.x * v0.x + v0.y * v0.y) + (v0.z * v0.z + v0.w * v0.w) + (v1.x * v1.x + v1.y * v1.y) + (v1.z * v1.z + v1.w * v1.w);
            af[ks] = __builtin_bit_cast(h16x8, pk8(v0, v1));
#pragma unroll
            for (int nt = 0; nt < 3; ++nt) { const h16x8 bf = *(const LAS h16x8*)(F.lds + (16 * nt + fr) * WRS + ks * 64 + fq * 16);
                acc[nt] = __builtin_amdgcn_mfma_f32_16x16x32_f16(af[ks], bf, acc[nt], 0, 0, 0); }
        }
        ss += __shfl_xor(ss, 16); ss += __shfl_xor(ss, 32);
        const float rstd = rsqrtf(ss * (1.f / D) + EPS);
#pragma unroll
        for (int nt = 0; nt < 3; ++nt)
#pragma unroll
            for (int r = 0; r < 4; ++r) scr[(4 * fq + r) * 48 + 16 * nt + fr] = acc[nt][r];
        if (lane < 16) scr[16 * 48 + lane] = rstd;
        h16* hb = (h16*)(ws + WS_HB) + (size_t)row * D + fq * 8;
#pragma unroll
        for (int ks = 0; ks < 32; ++ks) { f32x4 a, b; unpk8(__builtin_bit_cast(u32x4, af[ks]), a, b);
            const f32x4 g0 = *(const f32x4*)(p.g_ffn + ks * 32 + fq * 8), g1 = *(const f32x4*)(p.g_ffn + ks * 32 + fq * 8 + 4);
            *(u32x4*)(hb + ks * 32) = pk8(a * g0 * rstd, b * g1 * rstd); }
        asm volatile("s_waitcnt lgkmcnt(0)" ::: "memory");
        int E0 = 0, E1 = 0, p0 = 0, p1 = 0; float g0 = 0.f, g1 = 0.f;
        if (lane < 16) {
            const float rs = scr[16 * 48 + lane]; const LAS float* lg = scr + lane * 48;
            int gs = 0; float best = lg[0];
#pragma unroll
            for (int n = 1; n < 4; ++n) { const float v = lg[n]; if (v > best) { best = v; gs = n; } }
            float den = 0.f;
#pragma unroll
            for (int n = 0; n < 4; ++n) den += expf((lg[n] - best) * rs);
            const float pg = 1.f / den;
            const LAS float* le = lg + 4 + gs * 8;
            int e0 = 0; float l0 = le[0];
#pragma unroll
            for (int n = 1; n < 8; ++n) { const float v = le[n]; if (v > l0) { l0 = v; e0 = n; } }
            int e1 = -1; float l1 = -3.0e38f;
#pragma unroll
            for (int n = 0; n < 8; ++n) { const float v = le[n]; if (n != e0 && v > l1) { l1 = v; e1 = n; } }
            const float w1 = expf((l1 - l0) * rs);
            g0 = pg / (1.f + w1); g1 = pg * w1 / (1.f + w1);
            E0 = gs * 8 + e0; E1 = gs * 8 + e1;
            p0 = atomicAdd((int*)hist + E0, 1); p1 = atomicAdd((int*)hist + E1, 1);
        }
        __syncthreads();
        if (F.tid < 32) { const int c = hist[F.tid]; hist[32 + F.tid] = c ? atomicAdd((int*)(ws + WS_CNT) + F.tid, c) : 0; }
        __syncthreads();
        if (lane < 16) { int* list = (int*)(ws + WS_LIST); float* gate = (float*)(ws + WS_GATE);
            list[(size_t)E0 * ECAP + hist[32 + E0] + p0] = 2 * row; gate[2 * row] = g0;
            list[(size_t)E1 * ECAP + hist[32 + E1] + p1] = 2 * row + 1; gate[2 * row + 1] = g1; }
        __syncthreads();
    }
    for (size_t i = ((size_t)F.vcu * 512 + F.tid) * 4; i < (size_t)T * PLE; i += (size_t)F.G * 512 * 4) { const f32x4 v = *(const f32x4*)(p.p + i); u32x2 w; w.x = pkh(v.x, v.y); w.y = pkh(v.z, v.w); *(u32x2*)((h16*)(ws + WS_P16) + i) = w; }
}

struct UnitMoe { int e, rt, pn, cnt; };
struct MoeOrder {
    int cnt[4], nt[4], j, x;
    __device__ void init(const int* gcnt, int bx) { x = bx & 7; j = bx >> 3;
#pragma unroll
        for (int q = 0; q < 4; ++q) { cnt[q] = gcnt[x + 8 * q]; nt[q] = (cnt[q] + 255) >> 8; } }
    __device__ bool next(int i, UnitMoe& u) const {
        int q = i * 32 + j;
#pragma unroll
        for (int k = 0; k < 4; ++k) { const int nu = nt[k] * 4; if (q < nu) { u.e = x + 8 * k; u.rt = q >> 2; u.pn = q & 3; u.cnt = cnt[k]; return true; } q -= nu; }
        return false;
    }
};
struct PhMup {
    static constexpr int KT = 16, LDA = 2048, LDB = 2048; static constexpr bool PERM = true, GATHER = true;
    using Unit = UnitMoe;
    MoeOrder S; unsigned char* ws;
    __device__ __forceinline__ bool next(int i, Unit& u) const { return S.next(i, u); }
    __device__ __forceinline__ const char* a_ptr(const Unit&) const { return (const char*)(ws + WS_HB); }
    __device__ __forceinline__ const char* b_ptr(const Unit& u) const { return (const char*)(ws + WS_W13) + ((size_t)u.e * 1024 + (size_t)u.pn * 256) * LDB; }
    __device__ __forceinline__ void a_off(const Unit& u, const int (&R)[2], const int (&C)[2], unsigned (&o)[2][2]) const {
        const int* list = (const int*)(ws + WS_LIST) + (size_t)u.e * ECAP;
#pragma unroll
        for (int h = 0; h < 2; ++h)
#pragma unroll
            for (int i = 0; i < 2; ++i) { int r = u.rt * 256 + h * 128 + R[i]; r = r < u.cnt ? r : u.cnt - 1; o[h][i] = (unsigned)((list[r] >> 1) * LDA + C[i] * 2); }
    }
    __device__ __forceinline__ bool epi(const f32x4 (&acc)[2][2][4][2], const Unit& u, int wr, int wc, int fr, int fq) const {
        const int* list = (const int*)(ws + WS_LIST) + (size_t)u.e * ECAP; h16* H = (h16*)(ws + WS_H);
        const int col0 = u.pn * 128 + wc * 32 + 8 * fq;
#pragma unroll
        for (int ai = 0; ai < 2; ++ai)
#pragma unroll
            for (int m = 0; m < 4; ++m) { const int r = u.rt * 256 + ai * 128 + wr * 64 + m * 16 + fr;
                if (r < u.cnt) { const int a = list[r]; f32x4 v0 = acc[ai][0][m][0], v1 = acc[ai][0][m][1];
#pragma unroll
                    for (int j = 0; j < 4; ++j) { v0[j] = v0[j] * fsig(v0[j]) * acc[ai][1][m][0][j]; v1[j] = v1[j] * fsig(v1[j]) * acc[ai][1][m][1][j]; }
                    *(u32x4*)(H + (size_t)a * DE + col0) = pk8(v0, v1); } }
        return false;
    }
};
struct PhMdn {
    static constexpr int KT = 8, LDA = 1024, LDB = 1024; static constexpr bool PERM = true, GATHER = true;
    using Unit = UnitMoe;
    MoeOrder S; unsigned char* ws;
    __device__ __forceinline__ bool next(int i, Unit& u) const { return S.next(i, u); }
    __device__ __forceinline__ const char* a_ptr(const Unit&) const { return (const char*)(ws + WS_H); }
    __device__ __forceinline__ const char* b_ptr(const Unit& u) const { return (const char*)(ws + WS_W2) + ((size_t)u.e * 1024 + (size_t)u.pn * 256) * LDB; }
    __device__ __forceinline__ void a_off(const Unit& u, const int (&R)[2], const int (&C)[2], unsigned (&o)[2][2]) const {
        const int* list = (const int*)(ws + WS_LIST) + (size_t)u.e * ECAP;
#pragma unroll
        for (int h = 0; h < 2; ++h)
#pragma unroll
            for (int i = 0; i < 2; ++i) { int r = u.rt * 256 + h * 128 + R[i]; r = r < u.cnt ? r : u.cnt - 1; o[h][i] = (unsigned)(list[r] * LDA + C[i] * 2); }
    }
    __device__ __forceinline__ bool epi(const f32x4 (&acc)[2][2][4][2], const Unit& u, int wr, int wc, int fr, int fq) const {
        const int* list = (const int*)(ws + WS_LIST) + (size_t)u.e * ECAP; h16* Y = (h16*)(ws + WS_Y); const float* gate = (const float*)(ws + WS_GATE);
        const int col0 = u.pn * 256 + wc * 32 + 8 * fq;
#pragma unroll
        for (int ai = 0; ai < 2; ++ai)
#pragma unroll
            for (int m = 0; m < 4; ++m) { const int r = u.rt * 256 + ai * 128 + wr * 64 + m * 16 + fr;
                if (r < u.cnt) { const int a = list[r]; const float g = gate[a];
#pragma unroll
                    for (int bj = 0; bj < 2; ++bj) *(u32x4*)(Y + (size_t)a * D + col0 + bj * 128) = pk8(acc[ai][bj][m][0] * g, acc[ai][bj][m][1] * g); } }
        return false;
    }
};
__device__ __forceinline__ void combine_phase(Frame& F) {
    const P& p = F.p; unsigned char* ws = p.ws; const int lane = F.lane;
    for (int m = F.vcu * NWAVES + F.wave; m < T; m += F.G * NWAVES) {
        f32x4* xr = (f32x4*)(p.out + (size_t)m * D) + lane; const u32x2* y0 = (const u32x2*)((const h16*)(ws + WS_Y) + (size_t)(2 * m) * D) + lane;
        f32x4 v[4]; float s = 0.f;
#pragma unroll
        for (int j = 0; j < 4; ++j) { v[j] = xr[64 * j]; const u32x2 a = y0[64 * j], b = y0[256 + 64 * j];
            const h16x4 ha = __builtin_bit_cast(h16x4, a), hb = __builtin_bit_cast(h16x4, b);
            v[j].x += (float)ha[0] + (float)hb[0]; v[j].y += (float)ha[1] + (float)hb[1]; v[j].z += (float)ha[2] + (float)hb[2]; v[j].w += (float)ha[3] + (float)hb[3];
            xr[64 * j] = v[j]; s += (v[j].x * v[j].x + v[j].y * v[j].y) + (v[j].z * v[j].z + v[j].w * v[j].w); }
        const float r = rsqrtf(wave_sum(s) * (1.f / D) + EPS);
        u32x2* o8 = (u32x2*)((h16*)(ws + WS_HB) + (size_t)m * D) + lane;
#pragma unroll
        for (int j = 0; j < 4; ++j) { const f32x4 gg = ((const f32x4*)p.g_ple)[lane + 64 * j]; u32x2 w; w.x = pkh(v[j].x * r * gg.x, v[j].y * r * gg.y); w.y = pkh(v[j].z * r * gg.z, v[j].w * r * gg.w); o8[64 * j] = w; }
    }
}
__device__ __forceinline__ void final_phase(Frame& F) {
    const P& p = F.p; const int lane = F.lane;
    for (int m = F.vcu * NWAVES + F.wave; m < T; m += F.G * NWAVES) {
        f32x4* xr = (f32x4*)(p.out + (size_t)m * D) + lane; f32x4 v[4]; float s = 0.f;
#pragma unroll
        for (int j = 0; j < 4; ++j) { v[j] = xr[64 * j]; s += (v[j].x * v[j].x + v[j].y * v[j].y) + (v[j].z * v[j].z + v[j].w * v[j].w); }
        const float r = rsqrtf(wave_sum(s) * (1.f / D) + EPS);
#pragma unroll
        for (int j = 0; j < 4; ++j) { const f32x4 gg = ((const f32x4*)p.g_final)[lane + 64 * j]; xr[64 * j] = v[j] * gg * r; }
    }
}

typedef short s16x8 __attribute__((ext_vector_type(8)));
__device__ __forceinline__ unsigned cvt_pk_bf16(float lo, float hi) { unsigned r; asm volatile("v_cvt_pk_bf16_f32 %0, %1, %2" : "=v"(r) : "v"(lo), "v"(hi)); return r; }
__device__ __forceinline__ unsigned lds_addr(LAS unsigned char* p) { return (unsigned)(size_t)p; }
#define TR2(lo, hi, a0, a1) asm volatile("ds_read_b64_tr_b16 %0, %2\n\tds_read_b64_tr_b16 %1, %3" : "=&v"(lo), "=&v"(hi) : "v"(a0), "v"(a1) : "memory")
#define TRFRAG(T, lo, hi) __builtin_bit_cast(T, (u32x4){(lo).x, (lo).y, (hi).x, (hi).y})

constexpr int GM_RS = 1056;
__device__ __forceinline__ void gmlp_phase(Frame& F) {
    const P& p = F.p; unsigned char* ws = p.ws; const int lane = F.lane, w = F.wave, fr = lane & 15, fq = lane >> 4;
    const f32x4 lg0 = *(const f32x4*)(p.gm_ln_g + 8 * lane), lg1 = *(const f32x4*)(p.gm_ln_g + 8 * lane + 4), lb0 = *(const f32x4*)(p.gm_ln_b + 8 * lane), lb1 = *(const f32x4*)(p.gm_ln_b + 8 * lane + 4);
    for (int tile = F.vcu; tile < T / 128; tile += F.G) {
        const size_t t0 = (size_t)tile * 128;
        const h16* vb = (const h16*)(ws + WS_VB); h16* ub = (h16*)(ws + WS_UB);
#pragma unroll 4
        for (int i = 0; i < 16; ++i) { const int t = w + 8 * i; f32x4 a, b; unpk8(*(const u32x4*)(vb + (t0 + t) * 512 + 8 * lane), a, b);
            const float mean = wave_sum((a.x + a.y) + (a.z + a.w) + (b.x + b.y) + (b.z + b.w)) * (1.f / 512);
            a = a - mean; b = b - mean;
            const float r = rsqrtf(wave_sum((a.x * a.x + a.y * a.y) + (a.z * a.z + a.w * a.w) + (b.x * b.x + b.y * b.y) + (b.z * b.z + b.w * b.w)) * (1.f / 512) + EPS);
            *(LAS u32x4*)(F.lds + t * GM_RS + lane * 16) = pk8(a * r * lg0 + lb0, b * r * lg1 + lb1); }
        __syncthreads();
        const int g = w; const h16* Wg = (const h16*)(ws + WS_WSP) + (size_t)g * 128 * 128;
        const unsigned trbase = lds_addr(F.lds) + (8 * fq + (fr >> 2)) * GM_RS + g * 128 + (lane & 3) * 8;
#pragma unroll
        for (int half = 0; half < 2; ++half) {
            f32x4 acc[4][4];
#pragma unroll
            for (int a = 0; a < 4; ++a)
#pragma unroll
                for (int c = 0; c < 4; ++c) acc[a][c] = (f32x4){0.f, 0.f, 0.f, 0.f};
#pragma unroll
            for (int ks = 0; ks < 4; ++ks) { if (2 * ks > 4 * half + 3) continue;
                h16x8 wf[4];
#pragma unroll
                for (int m4 = 0; m4 < 4; ++m4) { const int mi = 4 * half + m4; if (mi >= 2 * ks) wf[m4] = *(const h16x8*)(Wg + (16 * mi + fr) * 128 + 32 * ks + 8 * fq); }
                u32x2 lo[4], hi[4];
#pragma unroll
                for (int c = 0; c < 4; ++c) TR2(lo[c], hi[c], trbase + (32 * ks) * GM_RS + c * 32, trbase + (32 * ks + 4) * GM_RS + c * 32);
                asm volatile("s_waitcnt lgkmcnt(0)" : "+v"(lo[0]), "+v"(hi[0]), "+v"(lo[1]), "+v"(hi[1]), "+v"(lo[2]), "+v"(hi[2]), "+v"(lo[3]), "+v"(hi[3]) :: "memory");
                __builtin_amdgcn_sched_barrier(0);
#pragma unroll
                for (int c = 0; c < 4; ++c) { const h16x8 vf = TRFRAG(h16x8, lo[c], hi[c]);
#pragma unroll
                    for (int m4 = 0; m4 < 4; ++m4) { const int mi = 4 * half + m4; if (mi >= 2 * ks) acc[m4][c] = __builtin_amdgcn_mfma_f32_16x16x32_f16(vf, wf[m4], acc[m4][c], 0, 0, 0); } }
            }
#pragma unroll
            for (int m4 = 0; m4 < 4; ++m4) { const int t = 16 * (4 * half + m4) + fr; const float bias = p.gm_b_sp[g * 128 + t];
#pragma unroll
                for (int c = 0; c < 4; ++c) { h16* up = ub + (t0 + t) * 512 + g * 64 + 16 * c + 4 * fq; const u32x2 ur = *(const u32x2*)up; const h16x4 uh = __builtin_bit_cast(h16x4, ur);
                    u32x2 o; o.x = pkh((float)uh[0] * (acc[m4][c][0] + bias), (float)uh[1] * (acc[m4][c][1] + bias)); o.y = pkh((float)uh[2] * (acc[m4][c][2] + bias), (float)uh[3] * (acc[m4][c][3] + bias));
                    *(u32x2*)up = o; } }
        }
        __syncthreads();
        const f32x4 n0 = *(const f32x4*)(p.hg_norm_g + 8 * lane), n1 = *(const f32x4*)(p.hg_norm_g + 8 * lane + 4);
#pragma unroll 4
        for (int i = 0; i < 16; ++i) { const size_t row = t0 + w + 8 * i; f32x4 a, b, ga, gb;
            unpk8(*(const u32x4*)((const h16*)(ws + WS_IB) + row * 512 + 8 * lane), a, b); unpk8(*(const u32x4*)((const h16*)(ws + WS_OB) + row * 512 + 8 * lane), ga, gb);
            float ss = (a.x * a.x + a.y * a.y) + (a.z * a.z + a.w * a.w) + (b.x * b.x + b.y * b.y) + (b.z * b.z + b.w * b.w);
            ss += __shfl_xor(ss, 1); ss += __shfl_xor(ss, 2); ss += __shfl_xor(ss, 4); ss += __shfl_xor(ss, 8);
            const float r = rsqrtf(ss * (1.f / 128) + EPS);
#pragma unroll
            for (int j = 0; j < 4; ++j) { a[j] = a[j] * r * n0[j] * fsig(ga[j]); b[j] = b[j] * r * n1[j] * fsig(gb[j]); }
            *(u32x4*)((h16*)(ws + WS_QB) + row * 512 + 8 * lane) = pk8(a, b); }
    }
}

constexpr int HQ_RS = 272, HE_RS = 288, HI_RS = 80, HS_RS = 80, HA_RS = 144;
constexpr int HG_QD = 0, HG_KI = 17408, HG_KE = 34816, HG_I = 53248, HG_S = 58368, HG_ATT = 68608, HG_TOT = 77824, HG_DEC = 79872;
__device__ __forceinline__ void hgrn_phase(Frame& F) {
    const P& p = F.p; unsigned char* ws = p.ws; const int tid = F.tid, lane = F.lane, w = F.wave, fr = lane & 15, fq = lane >> 4;
    constexpr float L2E = 1.4426950408889634f;
    LAS unsigned char* L = F.lds; const unsigned LA = lds_addr(L);
    for (int item = F.vcu; item < 256; item += F.G) {
        const int bh = item >> 2, sl = item & 3, b = bh >> 2, h = bh & 3;
        const int k = tid & 127, tq = tid >> 7;
        const h16* qb = (const h16*)(ws + WS_QB) + ((size_t)b * SEQ + tq * 16) * 512 + h * 128 + k;
        const h16* fb = (const h16*)(ws + WS_FB) + ((size_t)b * SEQ + tq * 16) * 512 + h * 128 + k;
        h16* ib = (h16*)(ws + WS_IB) + (size_t)b * SEQ * 512 + h * 128 + sl * 32;
        const int is = tid >> 3, iv4 = (tid & 7) * 4;
        f32x4 S0 = {0.f, 0.f, 0.f, 0.f}, S1 = {0.f, 0.f, 0.f, 0.f};
        for (int i = tid; i < 128 * HS_RS / 4; i += 512) ((LAS unsigned*)(L + HG_S))[i] = 0u;
        h16 rq[16], rf[16]; u32x2 ri;
#pragma unroll
        for (int j = 0; j < 16; ++j) { rq[j] = qb[(size_t)j * 512]; rf[j] = fb[(size_t)j * 512]; }
        ri = *(const u32x2*)(ib + (size_t)is * 512 + iv4);
        for (int c = 0; c < SEQ / 64; ++c) {
            float qv[16], lf[16]; const h16x4 ih = __builtin_bit_cast(h16x4, ri);
#pragma unroll
            for (int j = 0; j < 16; ++j) { qv[j] = (float)rq[j]; lf[j] = (float)rf[j]; }
            if (c + 1 < SEQ / 64) {
#pragma unroll
                for (int j = 0; j < 16; ++j) { rq[j] = qb[((size_t)(c + 1) * 64 + j) * 512]; rf[j] = fb[((size_t)(c + 1) * 64 + j) * 512]; }
                ri = *(const u32x2*)(ib + ((size_t)(c + 1) * 64 + is) * 512 + iv4);
            }
            float run[16]; float accs = 0.f;
#pragma unroll
            for (int j = 0; j < 16; ++j) { accs += lf[j]; run[j] = accs; }
            ((LAS float*)(L + HG_TOT))[tq * 128 + k] = accs;
            __syncthreads();
            float off = 0.f, tot = 0.f;
#pragma unroll
            for (int q = 0; q < 4; ++q) { const float tv = ((LAS float*)(L + HG_TOT))[q * 128 + k]; tot += tv; off += (q < tq) ? tv : 0.f; }
            const float EL = __builtin_amdgcn_exp2f(tot * L2E);
#pragma unroll
            for (int j = 0; j < 16; j += 2) { float qd[2], ki[2], ke[2];
#pragma unroll
                for (int u = 0; u < 2; ++u) { const float E = __builtin_amdgcn_exp2f((run[j + u] + off) * L2E), rE = __builtin_amdgcn_rcpf(E), kf = 1.f - __builtin_amdgcn_exp2f(lf[j + u] * L2E);
                    qd[u] = qv[j + u] * E; ki[u] = kf * rE; ke[u] = ki[u] * EL; }
                const unsigned pq = cvt_pk_bf16(qd[0], qd[1]), pi = cvt_pk_bf16(ki[0], ki[1]), pe = cvt_pk_bf16(ke[0], ke[1]); const int t = tq * 16 + j;
                *(LAS unsigned short*)(L + HG_QD + t * HQ_RS + k * 2) = (unsigned short)(pq & 0xffffu); *(LAS unsigned short*)(L + HG_QD + (t + 1) * HQ_RS + k * 2) = (unsigned short)(pq >> 16);
                *(LAS unsigned short*)(L + HG_KI + t * HQ_RS + k * 2) = (unsigned short)(pi & 0xffffu); *(LAS unsigned short*)(L + HG_KI + (t + 1) * HQ_RS + k * 2) = (unsigned short)(pi >> 16);
                *(LAS unsigned short*)(L + HG_KE + t * HE_RS + k * 2) = (unsigned short)(pe & 0xffffu); *(LAS unsigned short*)(L + HG_KE + (t + 1) * HE_RS + k * 2) = (unsigned short)(pe >> 16); }
            if (tq == 0) ((LAS float*)(L + HG_DEC))[k] = EL;
            { u32x2 iw; iw.x = cvt_pk_bf16((float)ih[0], (float)ih[1]); iw.y = cvt_pk_bf16((float)ih[2], (float)ih[3]); *(LAS u32x2*)(L + HG_I + is * HI_RS + iv4 * 2) = iw; }
            __syncthreads();
            { const int mi = w >> 1;
#pragma unroll
              for (int nn = 0; nn < 2; ++nn) { const int ni = 2 * (w & 1) + nn; f32x4 at = {0.f, 0.f, 0.f, 0.f};
                if (ni <= mi) {
#pragma unroll
                    for (int ks = 0; ks < 4; ++ks) { const s16x8 qf = *(const LAS s16x8*)(L + HG_QD + (16 * mi + fr) * HQ_RS + 64 * ks + 16 * fq), kf = *(const LAS s16x8*)(L + HG_KI + (16 * ni + fr) * HQ_RS + 64 * ks + 16 * fq);
                        at = __builtin_amdgcn_mfma_f32_16x16x32_bf16(kf, qf, at, 0, 0, 0); }
#pragma unroll
                    for (int r = 0; r < 4; ++r) at[r] = (16 * mi + fr >= 16 * ni + 4 * fq + r) ? at[r] : 0.f;
                }
                u32x2 aw; aw.x = cvt_pk_bf16(at[0], at[1]); aw.y = cvt_pk_bf16(at[2], at[3]);
                *(LAS u32x2*)(L + HG_ATT + (16 * mi + fr) * HA_RS + (16 * ni + 4 * fq) * 2) = aw; } }
            __syncthreads();
            { const int mi = w >> 1, vi = w & 1;
              const unsigned trq = (8 * fq + (fr >> 2)), trp = (lane & 3) * 8;
              u32x2 il[2][2], ih2[2][2], sl_[4], sh_[4], kl[2], kh[2];
#pragma unroll
              for (int ks = 0; ks < 2; ++ks)
#pragma unroll
                  for (int vb = 0; vb < 2; ++vb) TR2(il[ks][vb], ih2[ks][vb], LA + HG_I + (32 * ks + trq) * HI_RS + vb * 32 + trp, LA + HG_I + (32 * ks + 4 + trq) * HI_RS + vb * 32 + trp);
#pragma unroll
              for (int ks = 0; ks < 4; ++ks) TR2(sl_[ks], sh_[ks], LA + HG_S + (32 * ks + trq) * HS_RS + vi * 32 + trp, LA + HG_S + (32 * ks + 4 + trq) * HS_RS + vi * 32 + trp);
#pragma unroll
              for (int ks = 0; ks < 2; ++ks) TR2(kl[ks], kh[ks], LA + HG_KE + (32 * ks + trq) * HE_RS + w * 32 + trp, LA + HG_KE + (32 * ks + 4 + trq) * HE_RS + w * 32 + trp);
              asm volatile("s_waitcnt lgkmcnt(0)" : "+v"(il[0][0]), "+v"(ih2[0][0]), "+v"(il[0][1]), "+v"(ih2[0][1]), "+v"(il[1][0]), "+v"(ih2[1][0]), "+v"(il[1][1]), "+v"(ih2[1][1]) :: "memory");
              asm volatile("" : "+v"(sl_[0]), "+v"(sh_[0]), "+v"(sl_[1]), "+v"(sh_[1]), "+v"(sl_[2]), "+v"(sh_[2]), "+v"(sl_[3]), "+v"(sh_[3]), "+v"(kl[0]), "+v"(kh[0]), "+v"(kl[1]), "+v"(kh[1]) :: "memory");
              __builtin_amdgcn_sched_barrier(0);
              f32x4 o = {0.f, 0.f, 0.f, 0.f};
#pragma unroll
              for (int ks = 0; ks < 2; ++ks) { const s16x8 ar = *(const LAS s16x8*)(L + HG_ATT + (16 * mi + fr) * HA_RS + 64 * ks + 16 * fq);
                  o = __builtin_amdgcn_mfma_f32_16x16x32_bf16(TRFRAG(s16x8, il[ks][vi], ih2[ks][vi]), ar, o, 0, 0, 0); }
#pragma unroll
              for (int ks = 0; ks < 4; ++ks) { const s16x8 qr = *(const LAS s16x8*)(L + HG_QD + (16 * mi + fr) * HQ_RS + 64 * ks + 16 * fq);
                  o = __builtin_amdgcn_mfma_f32_16x16x32_bf16(TRFRAG(s16x8, sl_[ks], sh_[ks]), qr, o, 0, 0, 0); }
              { u32x2 ow; ow.x = pkh(o[0], o[1]); ow.y = pkh(o[2], o[3]); *(u32x2*)(ib + ((size_t)c * 64 + 16 * mi + fr) * 512 + 16 * vi + 4 * fq) = ow; }
              const f32x4 dc = *(const LAS f32x4*)(L + HG_DEC + (16 * w + 4 * fq) * 4);
              S0 = S0 * dc; S1 = S1 * dc;
#pragma unroll
              for (int ks = 0; ks < 2; ++ks) { const s16x8 kf = TRFRAG(s16x8, kl[ks], kh[ks]);
                  S0 = __builtin_amdgcn_mfma_f32_16x16x32_bf16(kf, TRFRAG(s16x8, il[ks][0], ih2[ks][0]), S0, 0, 0, 0);
                  S1 = __builtin_amdgcn_mfma_f32_16x16x32_bf16(kf, TRFRAG(s16x8, il[ks][1], ih2[ks][1]), S1, 0, 0, 0); } }
            __syncthreads();
#pragma unroll
            for (int r = 0; r < 4; r += 2) { const unsigned a0 = cvt_pk_bf16(S0[r], S0[r + 1]), a1 = cvt_pk_bf16(S1[r], S1[r + 1]); const int kk = 16 * w + 4 * fq + r;
                *(LAS unsigned short*)(L + HG_S + kk * HS_RS + fr * 2) = (unsigned short)(a0 & 0xffffu); *(LAS unsigned short*)(L + HG_S + (kk + 1) * HS_RS + fr * 2) = (unsigned short)(a0 >> 16);
                *(LAS unsigned short*)(L + HG_S + kk * HS_RS + (16 + fr) * 2) = (unsigned short)(a1 & 0xffffu); *(LAS unsigned short*)(L + HG_S + (kk + 1) * HS_RS + (16 + fr) * 2) = (unsigned short)(a1 >> 16); }
        }
        __syncthreads();
    }
}

struct UnitUp { int pm, pn, half; };
struct PhUp {
    static constexpr int KT = 8, LDA = 1024, LDB = 1024; static constexpr bool PERM = true, GATHER = false;
    using Unit = UnitUp;
    g8::StaticOrder S; unsigned char* ws;
    __device__ __forceinline__ bool next(int i, Unit& u) const { g8::Tile t; if (!S.next(i >> 1, t)) return false; u.pm = t.pm; u.pn = t.pn; u.half = i & 1; return true; }
    __device__ __forceinline__ const char* a_ptr(const Unit& u) const { return (const char*)(ws + (u.half ? WS_QB : WS_UB)) + (size_t)u.pm * 256 * LDA; }
    __device__ __forceinline__ const char* b_ptr(const Unit& u) const { return (const char*)(ws + (u.half ? WS_WUB : WS_WUA)) + (size_t)u.pn * 256 * LDB; }
    __device__ __forceinline__ void a_off(const Unit&, const int (&)[2], const int (&)[2], unsigned (&)[2][2]) const {}
    __device__ __forceinline__ bool epi(f32x4 (&acc)[2][2][4][2], const Unit& u, int wr, int wc, int fr, int fq) const {
        const int row0 = u.pm * 256 + wr * 64 + fr, col0 = u.pn * 256 + wc * 32 + 8 * fq;
        h16* ga = (h16*)(ws + WS_GA); const h16* gb = (const h16*)(ws + WS_GB);
#pragma unroll
        for (int ai = 0; ai < 2; ++ai)
#pragma unroll
            for (int m = 0; m < 4; ++m) { const size_t off = (size_t)(row0 + ai * 128 + m * 16) * D + col0;
#pragma unroll
                for (int bj = 0; bj < 2; ++bj) { f32x4 b0, b1; unpk8(*(const u32x4*)(gb + off + bj * 128), b0, b1);
#pragma unroll
                    for (int j = 0; j < 4; ++j) { b0[j] = fmaxf(b0[j], 6.2e-5f); b1[j] = fmaxf(b1[j], 6.2e-5f); }
                    if (u.half == 0) { f32x4 a0, a1; unpk8(*(const u32x4*)(ga + off + bj * 128), a0, a1);
#pragma unroll
                        for (int j = 0; j < 4; ++j) { acc[ai][bj][m][0][j] *= a0[j] * __builtin_amdgcn_rcpf(b0[j]); acc[ai][bj][m][1][j] *= a1[j] * __builtin_amdgcn_rcpf(b1[j]); }
                    } else { *(u32x4*)(ga + off + bj * 128) = pk8(acc[ai][bj][m][0] * b0, acc[ai][bj][m][1] * b1); } }
                if (m & 1) asm volatile("" ::: "memory"); }
        return u.half == 0;
    }
};
struct PhOut {
    static constexpr int KT = 16, LDA = 2048, LDB = 2048; static constexpr bool PERM = false, GATHER = false;
    using Unit = g8::Tile;
    g8::StaticOrder S; unsigned char* ws; const float* x; float* out;
    __device__ __forceinline__ bool next(int i, Unit& u) const { return S.next(i, u); }
    __device__ __forceinline__ const char* a_ptr(const Unit& u) const { return (const char*)(ws + WS_GA) + (size_t)u.pm * 256 * LDA; }
    __device__ __forceinline__ const char* b_ptr(const Unit& u) const { return (const char*)(ws + WS_WOUT) + (size_t)u.pn * 256 * LDB; }
    __device__ __forceinline__ void a_off(const Unit&, const int (&)[2], const int (&)[2], unsigned (&)[2][2]) const {}
    __device__ __forceinline__ bool epi(const f32x4 (&acc)[2][2][4][2], const Unit& u, int wr, int wc, int fr, int fq) const {
        const int row0 = u.pm * 256 + wr * 64 + fr, col0 = u.pn * 256 + wc * 32 + 4 * fq;
#pragma unroll
        for (int ai = 0; ai < 2; ++ai)
#pragma unroll
            for (int m = 0; m < 4; ++m) { const size_t off = (size_t)(row0 + ai * 128 + m * 16) * D + col0;
#pragma unroll
                for (int bj = 0; bj < 2; ++bj)
#pragma unroll
                    for (int n = 0; n < 2; ++n) *(f32x4*)(out + off + bj * 128 + n * 16) = *(const f32x4*)(x + off + bj * 128 + n * 16) + acc[ai][bj][m][n];
                if (m & 1) asm volatile("" ::: "memory"); }
        return false;
    }
};
struct PhPle {
    static constexpr int KT = 4, LDA = 512, LDB = 512; static constexpr bool PERM = true, GATHER = false;
    using Unit = g8::Tile;
    g8::StaticOrder S; unsigned char* ws;
    __device__ __forceinline__ bool next(int i, Unit& u) const { return S.next(i, u); }
    __device__ __forceinline__ const char* a_ptr(const Unit& u) const { return (const char*)(ws + WS_P16) + (size_t)u.pm * 256 * LDA; }
    __device__ __forceinline__ const char* b_ptr(const Unit& u) const { return (const char*)(ws + WS_WPLE) + (size_t)u.pn * 256 * LDB; }
    __device__ __forceinline__ void a_off(const Unit&, const int (&)[2], const int (&)[2], unsigned (&)[2][2]) const {}
    __device__ __forceinline__ bool epi(const f32x4 (&acc)[2][2][4][2], const Unit& u, int wr, int wc, int fr, int fq) const {
        const int row0 = u.pm * 256 + wr * 64 + fr, col0 = u.pn * 256 + wc * 32 + 8 * fq; h16* pl = (h16*)(ws + WS_PL);
#pragma unroll
        for (int ai = 0; ai < 2; ++ai)
#pragma unroll
            for (int m = 0; m < 4; ++m) { const size_t off = (size_t)(row0 + ai * 128 + m * 16) * D + col0;
#pragma unroll
                for (int bj = 0; bj < 2; ++bj) *(u32x4*)(pl + off + bj * 128) = pk8(acc[ai][bj][m][0], acc[ai][bj][m][1]); }
        return false;
    }
};
struct PhPg {
    static constexpr int KT = 16, LDA = 2048, LDB = 2048; static constexpr bool PERM = true, GATHER = false;
    using Unit = g8::Tile;
    g8::StaticOrder S; unsigned char* ws; float* out;
    __device__ __forceinline__ bool next(int i, Unit& u) const { return S.next(i, u); }
    __device__ __forceinline__ const char* a_ptr(const Unit& u) const { return (const char*)(ws + WS_HB) + (size_t)u.pm * 256 * LDA; }
    __device__ __forceinline__ const char* b_ptr(const Unit& u) const { return (const char*)(ws + WS_WPG) + (size_t)u.pn * 256 * LDB; }
    __device__ __forceinline__ void a_off(const Unit&, const int (&)[2], const int (&)[2], unsigned (&)[2][2]) const {}
    __device__ __forceinline__ bool epi(const f32x4 (&acc)[2][2][4][2], const Unit& u, int wr, int wc, int fr, int fq) const {
        const int row0 = u.pm * 256 + wr * 64 + fr, col0 = u.pn * 256 + wc * 32 + 8 * fq; const h16* pl = (const h16*)(ws + WS_PL);
#pragma unroll
        for (int ai = 0; ai < 2; ++ai)
#pragma unroll
            for (int m = 0; m < 4; ++m) { const size_t off = (size_t)(row0 + ai * 128 + m * 16) * D + col0;
#pragma unroll
                for (int bj = 0; bj < 2; ++bj) { f32x4 p0, p1; unpk8(*(const u32x4*)(pl + off + bj * 128), p0, p1);
                    f32x4 x0 = *(const f32x4*)(out + off + bj * 128), x1 = *(const f32x4*)(out + off + bj * 128 + 4);
#pragma unroll
                    for (int j = 0; j < 4; ++j) { x0[j] += fsig(acc[ai][bj][m][0][j]) * p0[j]; x1[j] += fsig(acc[ai][bj][m][1][j]) * p1[j]; }
                    *(f32x4*)(out + off + bj * 128) = x0; *(f32x4*)(out + off + bj * 128 + 4) = x1; }
                asm volatile("" ::: "memory"); }
        return false;
    }
};

struct Args { P p; int ph_lo, ph_hi, use_bar, pad; };
__global__ void __launch_bounds__(512, 2) mega(Args a) {
    extern __shared__ __attribute__((aligned(16))) unsigned char lds_raw[];
    Frame F; F.lds = (LAS unsigned char*)lds_raw; F.tid = threadIdx.x; F.lane = F.tid & 63; F.wave = __builtin_amdgcn_readfirstlane(F.tid >> 6);
    F.G = gridDim.x; { const int bx = blockIdx.x; F.vcu = (F.G % 8 == 0) ? (bx % 8) * (F.G / 8) + bx / 8 : bx; }
    F.p = a.p;
    volatile LAS unsigned* MISC = (volatile LAS unsigned*)(F.lds + MISC_OFF);
    if (F.tid < 32) MISC[F.tid] = 0u;
    __syncthreads();
    XcdBarrier bar; bar.bar = (unsigned*)(a.p.ws + WS_CTL); bar.x = 0; bar.st = nullptr;
    if (a.use_bar) bar = xcd_barrier_post((unsigned*)(a.p.ws + WS_CTL), MISC + 8);
    const int lo = a.ph_lo, hi = a.ph_hi;
#define IN(k) (lo <= (k) && (k) < hi)
#define SEAM(k) do { if (IN(k) && IN((k) + 1)) xcd_barrier(bar); } while (0)
    unsigned char* ws = a.p.ws;
    if (IN(0)) { p0_prologue(F); } SEAM(0);
    if (IN(1)) { PhIn ph; ph.S.init(T / 256, INC / 256, F.G, (int)blockIdx.x); ph.ws = ws; g8::gemm_phase(F.lds, ph); } SEAM(1);
    if (IN(2)) { hgrn_phase(F); } SEAM(2);
    if (IN(3)) { gmlp_phase(F); } SEAM(3);
    if (IN(4)) { PhUp ph; ph.S.init(T / 256, D / 256, F.G, (int)blockIdx.x); ph.ws = ws; g8::gemm_phase(F.lds, ph); } SEAM(4);
    if (IN(5)) { PhOut ph; ph.S.init(T / 256, D / 256, F.G, (int)blockIdx.x); ph.ws = ws; ph.x = a.p.x; ph.out = a.p.out; g8::gemm_phase(F.lds, ph); } SEAM(5);
    if (IN(6)) { route_phase(F); } SEAM(6);
    if (IN(7)) { PhMup ph; ph.S.init((const int*)(ws + WS_CNT), (int)blockIdx.x); ph.ws = ws; g8::gemm_phase(F.lds, ph); } SEAM(7);
    if (IN(8)) { PhMdn ph; ph.S.init((const int*)(ws + WS_CNT), (int)blockIdx.x); ph.ws = ws; g8::gemm_phase(F.lds, ph); } SEAM(8);
    if (IN(9)) { combine_phase(F); } SEAM(9);
    if (IN(10)) {
#ifndef SUB10
#define SUB10 3
#endif
        if (SUB10 & 1) { PhPle ph; ph.S.init(T / 256, D / 256, F.G, (int)blockIdx.x); ph.ws = ws; g8::gemm_phase(F.lds, ph); }
        if (SUB10 & 2) { PhPg ph; ph.S.init(T / 256, D / 256, F.G, (int)blockIdx.x); ph.ws = ws; ph.out = a.p.out; g8::gemm_phase(F.lds, ph); }
    } SEAM(10);
    if (IN(11)) { final_phase(F); }
#undef IN
#undef SEAM
}

__global__ void n_p16(P p) { size_t i = ((size_t)blockIdx.x * 256 + threadIdx.x) * 4; f32x4 v = *(const f32x4*)(p.p + i); u32x2 w; w.x = pkh(v.x, v.y); w.y = pkh(v.z, v.w); *(u32x2*)((h16*)(p.ws + WS_P16) + i) = w; }

static void launch_mega(const P& p, int lo, int hi, int use_bar, hipStream_t stream) {
    Args a{}; a.p = p; a.ph_lo = lo; a.ph_hi = hi; a.use_bar = use_bar; a.pad = 0;
    hipLaunchKernelGGL(mega, dim3(256), dim3(512), LDS_BYTES, stream, a);
}

extern "C" void kernel_launch(void* const* d_in, const int* in_sizes, int n_in, void* d_out, int out_size, void* d_ws, size_t ws_size, hipStream_t stream) {
    static int ready = 0;
    if (!ready) {
        if (n_in != 23 || ws_size < WS_END) { fprintf(stderr, "kernel_launch: unexpected n_in %d / ws_size %zu\n", n_in, ws_size); ready = -1; return; }
        if (hipFuncSetAttribute((const void*)mega, hipFuncAttributeMaxDynamicSharedMemorySize, LDS_BYTES) != hipSuccess) { fprintf(stderr, "kernel_launch: hipFuncSetAttribute failed\n"); ready = -1; return; }
        ready = 1;
    }
    if (ready < 0) return;
    P p{};
    const float** f = (const float**)&p;
    for (int i = 0; i < 23; ++i) f[i] = (const float*)d_in[i];
    p.out = (float*)d_out; p.ws = (unsigned char*)d_ws;
    (void)hipMemsetAsync((char*)d_ws + WS_CNT, 0, 4096 + XCD_BAR_WORDS * 4, stream);
#ifdef OPTMASK
    launch_mega(p, 0, 1, 0, stream);
    if (OPTMASK & 2) launch_mega(p, 1, 2, 0, stream);
    else { n_rmsnorm<<<T / 4, 256, 0, stream>>>(p.x, p.g_mix, (h16*)(p.ws + WS_HB)); ngemm<0, F_in><<<dim3(INC / 64, T / 64), 256, 0, stream>>>(INC, D, F_in{p}); }
    if (OPTMASK & 4) launch_mega(p, 2, 3, 0, stream); else n_hgrn<<<64, 128, 0, stream>>>(p);
    if (OPTMASK & 8) launch_mega(p, 3, 4, 0, stream); else { n_lnv<<<T / 4, 256, 0, stream>>>(p); n_gmlp<<<dim3(T / 128, 8), 256, 0, stream>>>(p); n_hgfin<<<T / 4, 256, 0, stream>>>(p); }
    if (OPTMASK & 16) launch_mega(p, 4, 5, 0, stream); else ngemm<1, F_up><<<dim3(D / 64, T / 64), 256, 0, stream>>>(D, 512, F_up{p});
    if (OPTMASK & 32) launch_mega(p, 5, 6, 0, stream); else ngemm<0, F_out><<<dim3(D / 64, T / 64), 256, 0, stream>>>(D, D, F_out{p});
    if (OPTMASK & 64) launch_mega(p, 6, 7, 0, stream); else n_route<<<T / 4, 256, 0, stream>>>(p);
    if (OPTMASK & 128) launch_mega(p, 7, 8, 0, stream); else ngemm<1, F_mup><<<dim3(DE / 64, ECAP / 64, NE), 256, 0, stream>>>(DE, D, F_mup{p});
    if (OPTMASK & 256) launch_mega(p, 8, 9, 0, stream); else ngemm<0, F_mdn><<<dim3(D / 64, ECAP / 64, NE), 256, 0, stream>>>(D, DE, F_mdn{p});
    if (OPTMASK & 512) launch_mega(p, 9, 10, 0, stream); else n_combine<<<T / 4, 256, 0, stream>>>(p);
    if (OPTMASK & 1024) { if (!(OPTMASK & 64)) n_p16<<<T * PLE / 1024, 256, 0, stream>>>(p);
        if (!(SUB10 & 1)) ngemm<0, F_ple><<<dim3(D / 64, T / 64), 256, 0, stream>>>(D, PLE, F_ple{p});
        launch_mega(p, 10, 11, 0, stream);
        if (!(SUB10 & 2)) ngemm<0, F_pg><<<dim3(D / 64, T / 64), 256, 0, stream>>>(D, D, F_pg{p}); }
    else { ngemm<0, F_ple><<<dim3(D / 64, T / 64), 256, 0, stream>>>(D, PLE, F_ple{p}); ngemm<0, F_pg><<<dim3(D / 64, T / 64), 256, 0, stream>>>(D, D, F_pg{p}); }
    if (OPTMASK & 2048) launch_mega(p, 11, 12, 0, stream); else n_final<<<T / 4, 256, 0, stream>>>(p);
#else
    launch_mega(p, 0, 12, 1, stream);
#endif
}
```

```cpp
#include <hip/hip_runtime.h>
#include <cstdio>
#include <cstdint>

typedef _Float16 h16;
constexpr int T = 32768, D = 1024, SEQ = 2048, NB = 16, INC = 5120, PLE = 256;
constexpr int NE = 32, DE = 512, NA = 2 * T, ECAP = T;
constexpr float EPS = 1e-6f;

constexpr size_t MiB = 1024 * 1024;
constexpr size_t WS_HB = 0;
constexpr size_t WS_Z = 64 * MiB;
constexpr size_t WS_UB = WS_Z;
constexpr size_t WS_VB = WS_Z + 32 * MiB;
constexpr size_t WS_QB = WS_Z + 64 * MiB;
constexpr size_t WS_FB = WS_Z + 96 * MiB;
constexpr size_t WS_IB = WS_Z + 128 * MiB;
constexpr size_t WS_OB = WS_Z + 160 * MiB;
constexpr size_t WS_GA = WS_Z + 192 * MiB;
constexpr size_t WS_GB = WS_Z + 256 * MiB;
constexpr size_t WS_H = WS_Z;
constexpr size_t WS_Y = WS_Z + 64 * MiB;
constexpr size_t WS_PL = WS_Z + 192 * MiB;
constexpr size_t WS_W = 384 * MiB;
constexpr size_t WS_MISC = 498 * MiB;
constexpr size_t WS_LIST = WS_MISC;
constexpr size_t WS_GATE = WS_MISC + 4 * MiB;
constexpr size_t WS_CNT = WS_MISC + 5 * MiB;
constexpr size_t WS_END = WS_MISC + 6 * MiB;

struct P {
    const float *x, *p, *g_mix, *w_in, *gm_ln_g, *gm_ln_b, *gm_w_sp, *gm_b_sp, *w_up_a, *hg_lb, *hg_norm_g, *w_up_b, *w_out, *g_ffn,
        *w_grp, *w_exp, *w1, *w3, *w2, *g_ple, *w_pg, *w_ple, *g_final;
    float* out; unsigned char* ws;
};

__device__ __forceinline__ float sigm(float v) { return 1.f / (1.f + expf(-v)); }
__device__ __forceinline__ float gelu_t(float v) { return v * sigm(1.5957691216057308f * (v + 0.044715f * v * v * v)); }
__device__ __forceinline__ float wave_sum(float v) {
#pragma unroll
    for (int o = 1; o < 64; o <<= 1) v += __shfl_xor(v, o);
    return v;
}

__global__ void n_rmsnorm(const float* x, const float* g, h16* out) {
    int row = blockIdx.x * 4 + (threadIdx.x >> 6), lane = threadIdx.x & 63;
    const float* xr = x + (size_t)row * D; float v[16]; float s = 0.f;
    for (int j = 0; j < 16; ++j) { v[j] = xr[lane + 64 * j]; s += v[j] * v[j]; }
    float r = rsqrtf(wave_sum(s) * (1.f / D) + EPS);
    for (int j = 0; j < 16; ++j) out[(size_t)row * D + lane + 64 * j] = (h16)(v[j] * r * g[lane + 64 * j]);
}

template <int DUAL, class F>
__global__ void __launch_bounds__(256) ngemm(int N, int K, F f) {
    __shared__ float As[DUAL + 1][16][65], Bs[DUAL + 1][16][65];
    const int M = f.rows(); const int r0 = blockIdx.y * 64, c0 = blockIdx.x * 64;
    if (r0 >= M) return;
    const int tx = threadIdx.x & 15, ty = threadIdx.x >> 4;
    float acc[DUAL + 1][4][4] = {};
    for (int k0 = 0; k0 < K; k0 += 16) {
        for (int w = 0; w <= DUAL; ++w)
            for (int i = threadIdx.x; i < 1024; i += 256) {
                int r = i >> 4, kk = i & 15; As[w][kk][r] = (r0 + r < M) ? f.fa(r0 + r, k0 + kk, w) : 0.f;
                int kb = i >> 6, c = i & 63; Bs[w][kb][c] = f.fb(k0 + kb, c0 + c, w);
            }
        __syncthreads();
        for (int w = 0; w <= DUAL; ++w)
#pragma unroll
            for (int kk = 0; kk < 16; ++kk) {
                float a[4], b[4];
#pragma unroll
                for (int i = 0; i < 4; ++i) { a[i] = As[w][kk][ty * 4 + i]; b[i] = Bs[w][kk][tx * 4 + i]; }
#pragma unroll
                for (int i = 0; i < 4; ++i)
#pragma unroll
                    for (int j = 0; j < 4; ++j) acc[w][i][j] += a[i] * b[j];
            }
        __syncthreads();
    }
    for (int i = 0; i < 4; ++i) for (int j = 0; j < 4; ++j) { int r = r0 + ty * 4 + i, c = c0 + tx * 4 + j; if (r < M) f.fe(r, c, acc[0][i][j], acc[DUAL][i][j]); }
}

struct F_in {
    P p;
    __device__ int rows() const { return T; }
    __device__ float fa(int r, int k, int) const { return (float)((const h16*)(p.ws + WS_HB))[(size_t)r * D + k]; }
    __device__ float fb(int k, int c, int) const { return p.w_in[(size_t)k * INC + c]; }
    __device__ void fe(int r, int c, float a, float) const {
        unsigned char* ws = p.ws; int part = c >> 9;
        if (part == 0) ((h16*)(ws + WS_UB))[(size_t)r * 512 + c] = (h16)gelu_t(a);
        else if (part == 1) ((h16*)(ws + WS_VB))[(size_t)r * 512 + c - 512] = (h16)gelu_t(a);
        else if (part == 2) ((h16*)(ws + WS_QB))[(size_t)r * 512 + c - 1024] = (h16)(a * sigm(a));
        else if (part == 3) { int j = c - 1536; float lb = 1.f / (1.f + expf(p.hg_lb[512 + j] - p.hg_lb[j])); float fv = lb + (1.f - lb) * sigm(a);
            ((h16*)(ws + WS_FB))[(size_t)r * 512 + j] = (h16)logf(fv); }
        else if (part == 4) ((h16*)(ws + WS_IB))[(size_t)r * 512 + c - 2048] = (h16)a;
        else if (part == 5) ((h16*)(ws + WS_OB))[(size_t)r * 512 + c - 2560] = (h16)a;
        else if (part < 8) ((h16*)(ws + WS_GA))[(size_t)r * D + c - 3072] = (h16)sigm(a);
        else ((h16*)(ws + WS_GB))[(size_t)r * D + c - 4096] = (h16)sigm(a);
    }
};

__global__ void n_lnv(P p) {
    int row = blockIdx.x * 4 + (threadIdx.x >> 6), lane = threadIdx.x & 63;
    h16* vr = (h16*)(p.ws + WS_VB) + (size_t)row * 512; float v[8]; float s = 0.f;
    for (int j = 0; j < 8; ++j) { v[j] = (float)vr[lane + 64 * j]; s += v[j]; }
    float mu = wave_sum(s) * (1.f / 512); float q = 0.f;
    for (int j = 0; j < 8; ++j) { v[j] -= mu; q += v[j] * v[j]; }
    float r = rsqrtf(wave_sum(q) * (1.f / 512) + EPS);
    for (int j = 0; j < 8; ++j) { int c = lane + 64 * j; vr[c] = (h16)(v[j] * r * p.gm_ln_g[c] + p.gm_ln_b[c]); }
}
__global__ void __launch_bounds__(256) n_gmlp(P p) {
    __shared__ float vs[128][65];
    const int tile = blockIdx.x, g = blockIdx.y; const size_t t0 = (size_t)tile * 128;
    const h16* vb = (const h16*)(p.ws + WS_VB); h16* ub = (h16*)(p.ws + WS_UB);
    for (int i = threadIdx.x; i < 128 * 64; i += 256) { int s = i >> 6, d = i & 63; vs[s][d] = (float)vb[(t0 + s) * 512 + g * 64 + d]; }
    __syncthreads();
    for (int i = threadIdx.x; i < 128 * 64; i += 256) { int t = i >> 6, d = i & 63; float acc = 0.f;
        const float* w = p.gm_w_sp + ((size_t)g * 128 + t) * 128;
        for (int s = 0; s <= t; ++s) acc += w[s] * vs[s][d];
        acc += p.gm_b_sp[g * 128 + t];
        size_t o = (t0 + t) * 512 + g * 64 + d; ub[o] = (h16)((float)ub[o] * acc); }
}
__global__ void __launch_bounds__(128) n_hgrn(P p) {
    __shared__ float fk[128], kk[128], qk[128];
    const int b = blockIdx.x >> 2, h = blockIdx.x & 3, v = threadIdx.x;
    const h16* qb = (const h16*)(p.ws + WS_QB); const h16* fb = (const h16*)(p.ws + WS_FB); h16* ib = (h16*)(p.ws + WS_IB);
    float S[128];
#pragma unroll
    for (int k = 0; k < 128; ++k) S[k] = 0.f;
    for (int t = 0; t < SEQ; ++t) {
        size_t o = ((size_t)b * SEQ + t) * 512 + h * 128 + v;
        float f = expf((float)fb[o]); fk[v] = f; kk[v] = 1.f - f; qk[v] = (float)qb[o]; float iv = (float)ib[o];
        __syncthreads();
        float acc = 0.f;
#pragma unroll
        for (int k = 0; k < 128; ++k) { S[k] = fk[k] * S[k] + kk[k] * iv; acc += S[k] * qk[k]; }
        __syncthreads();
        ib[o] = (h16)acc;
    }
}
__global__ void n_hgfin(P p) {
    int row = blockIdx.x * 4 + (threadIdx.x >> 6), lane = threadIdx.x & 63;
    const h16* ob = (const h16*)(p.ws + WS_IB) + (size_t)row * 512; const h16* og = (const h16*)(p.ws + WS_OB) + (size_t)row * 512; h16* yb = (h16*)(p.ws + WS_QB) + (size_t)row * 512;
    int c0 = (lane >> 4) * 128 + (lane & 15) * 8; float v[8]; float s = 0.f;
    for (int j = 0; j < 8; ++j) { v[j] = (float)ob[c0 + j]; s += v[j] * v[j]; }
    for (int o = 1; o < 16; o <<= 1) s += __shfl_xor(s, o);
    float r = rsqrtf(s * (1.f / 128) + EPS);
    for (int j = 0; j < 8; ++j) yb[c0 + j] = (h16)(v[j] * r * p.hg_norm_g[c0 + j] * sigm((float)og[c0 + j]));
}
struct F_up {
    P p;
    __device__ int rows() const { return T; }
    __device__ float fa(int r, int k, int w) const { return (float)((const h16*)(p.ws + (w ? WS_QB : WS_UB)))[(size_t)r * 512 + k]; }
    __device__ float fb(int k, int c, int w) const { return (w ? p.w_up_b : p.w_up_a)[(size_t)k * D + c]; }
    __device__ void fe(int r, int c, float a0, float a1) const { h16* ga = (h16*)(p.ws + WS_GA); const h16* gb = (const h16*)(p.ws + WS_GB); size_t o = (size_t)r * D + c;
        ga[o] = (h16)((float)ga[o] * a0 + (float)gb[o] * a1); }
};
struct F_out {
    P p;
    __device__ int rows() const { return T; }
    __device__ float fa(int r, int k, int) const { return (float)((const h16*)(p.ws + WS_GA))[(size_t)r * D + k]; }
    __device__ float fb(int k, int c, int) const { return p.w_out[(size_t)k * D + c]; }
    __device__ void fe(int r, int c, float a, float) const { size_t o = (size_t)r * D + c; p.out[o] = p.x[o] + a; }
};
__global__ void n_route(P p) {
    int row = blockIdx.x * 4 + (threadIdx.x >> 6), lane = threadIdx.x & 63;
    const float* xr = p.out + (size_t)row * D; float v[16]; float s = 0.f;
    for (int j = 0; j < 16; ++j) { v[j] = xr[lane + 64 * j]; s += v[j] * v[j]; }
    float r = rsqrtf(wave_sum(s) * (1.f / D) + EPS);
    h16* hb = (h16*)(p.ws + WS_HB) + (size_t)row * D;
    for (int j = 0; j < 16; ++j) { v[j] = v[j] * r * p.g_ffn[lane + 64 * j]; hb[lane + 64 * j] = (h16)v[j]; }
    __shared__ float lgs[4][40]; float* lg = lgs[threadIdx.x >> 6]; float* le = lg + 4;
    for (int n = 0; n < 4; ++n) { float a = 0.f; for (int j = 0; j < 16; ++j) a += v[j] * p.w_grp[(size_t)(lane + 64 * j) * 4 + n]; a = wave_sum(a); if (lane == 0) lg[n] = a; }
    for (int n = 0; n < 32; ++n) { float a = 0.f; for (int j = 0; j < 16; ++j) a += v[j] * p.w_exp[(size_t)(lane + 64 * j) * 32 + n]; a = wave_sum(a); if (lane == 0) le[n] = a; }
    if (lane == 0) {
        int gs = 0; for (int n = 1; n < 4; ++n) if (lg[n] > lg[gs]) gs = n;
        float den = 0.f; for (int n = 0; n < 4; ++n) den += expf(lg[n] - lg[gs]); float pg = 1.f / den;
        int e0 = 0; for (int n = 1; n < 8; ++n) if (le[gs * 8 + n] > le[gs * 8 + e0]) e0 = n;
        int e1 = (e0 == 0) ? 1 : 0; for (int n = 0; n < 8; ++n) if (n != e0 && le[gs * 8 + n] > le[gs * 8 + e1]) e1 = n;
        float l0 = le[gs * 8 + e0], l1 = le[gs * 8 + e1]; float w1 = expf(l1 - l0); float g0 = pg / (1.f + w1), g1 = pg * w1 / (1.f + w1);
        int* cnt = (int*)(p.ws + WS_CNT); int* list = (int*)(p.ws + WS_LIST); float* gate = (float*)(p.ws + WS_GATE);
        int E0 = gs * 8 + e0, E1 = gs * 8 + e1;
        int p0 = atomicAdd(&cnt[E0], 1); list[(size_t)E0 * ECAP + p0] = 2 * row; gate[2 * row] = g0;
        int p1 = atomicAdd(&cnt[E1], 1); list[(size_t)E1 * ECAP + p1] = 2 * row + 1; gate[2 * row + 1] = g1;
    }
}
struct F_mup {
    P p;
    __device__ int rows() const { return ((const int*)(p.ws + WS_CNT))[blockIdx.z]; }
    __device__ float fa(int r, int k, int) const { int a = ((const int*)(p.ws + WS_LIST))[(size_t)blockIdx.z * ECAP + r]; return (float)((const h16*)(p.ws + WS_HB))[(size_t)(a >> 1) * D + k]; }
    __device__ float fb(int k, int c, int w) const { return (w ? p.w3 : p.w1)[((size_t)blockIdx.z * D + k) * DE + c]; }
    __device__ void fe(int r, int c, float a0, float a1) const { int a = ((const int*)(p.ws + WS_LIST))[(size_t)blockIdx.z * ECAP + r];
        ((h16*)(p.ws + WS_H))[(size_t)a * DE + c] = (h16)(a0 * sigm(a0) * a1); }
};
struct F_mdn {
    P p;
    __device__ int rows() const { return ((const int*)(p.ws + WS_CNT))[blockIdx.z]; }
    __device__ float fa(int r, int k, int) const { int a = ((const int*)(p.ws + WS_LIST))[(size_t)blockIdx.z * ECAP + r]; return (float)((const h16*)(p.ws + WS_H))[(size_t)a * DE + k]; }
    __device__ float fb(int k, int c, int) const { return p.w2[((size_t)blockIdx.z * DE + k) * D + c]; }
    __device__ void fe(int r, int c, float a0, float) const { int a = ((const int*)(p.ws + WS_LIST))[(size_t)blockIdx.z * ECAP + r];
        ((h16*)(p.ws + WS_Y))[(size_t)a * D + c] = (h16)(a0 * ((const float*)(p.ws + WS_GATE))[a]); }
};
__global__ void n_combine(P p) {
    int row = blockIdx.x * 4 + (threadIdx.x >> 6), lane = threadIdx.x & 63;
    float* xr = p.out + (size_t)row * D; const h16* y0 = (const h16*)(p.ws + WS_Y) + (size_t)(2 * row) * D; float v[16]; float s = 0.f;
    for (int j = 0; j < 16; ++j) { int c = lane + 64 * j; v[j] = xr[c] + (float)y0[c] + (float)y0[D + c]; xr[c] = v[j]; s += v[j] * v[j]; }
    float r = rsqrtf(wave_sum(s) * (1.f / D) + EPS);
    h16* hb = (h16*)(p.ws + WS_HB) + (size_t)row * D;
    for (int j = 0; j < 16; ++j) hb[lane + 64 * j] = (h16)(v[j] * r * p.g_ple[lane + 64 * j]);
}
struct F_ple {
    P p;
    __device__ int rows() const { return T; }
    __device__ float fa(int r, int k, int) const { return p.p[(size_t)r * PLE + k]; }
    __device__ float fb(int k, int c, int) const { return p.w_ple[(size_t)k * D + c]; }
    __device__ void fe(int r, int c, float a, float) const { ((h16*)(p.ws + WS_PL))[(size_t)r * D + c] = (h16)a; }
};
struct F_pg {
    P p;
    __device__ int rows() const { return T; }
    __device__ float fa(int r, int k, int) const { return (float)((const h16*)(p.ws + WS_HB))[(size_t)r * D + k]; }
    __device__ float fb(int k, int c, int) const { return p.w_pg[(size_t)k * D + c]; }
    __device__ void fe(int r, int c, float a, float) const { size_t o = (size_t)r * D + c; p.out[o] = p.out[o] + sigm(a) * (float)((const h16*)(p.ws + WS_PL))[o]; }
};
__global__ void n_final(P p) {
    int row = blockIdx.x * 4 + (threadIdx.x >> 6), lane = threadIdx.x & 63;
    float* xr = p.out + (size_t)row * D; float v[16]; float s = 0.f;
    for (int j = 0; j < 16; ++j) { v[j] = xr[lane + 64 * j]; s += v[j] * v[j]; }
    float r = rsqrtf(wave_sum(s) * (1.f / D) + EPS);
    for (int j = 0; j < 16; ++j) xr[lane + 64 * j] = v[j] * r * p.g_final[lane + 64 * j];
}


#define LAS __attribute__((address_space(3)))
typedef _Float16 h16x8 __attribute__((ext_vector_type(8)));
typedef _Float16 h16x4 __attribute__((ext_vector_type(4)));
typedef _Float16 h16x2 __attribute__((ext_vector_type(2)));
typedef float f32x4 __attribute__((ext_vector_type(4)));
typedef float f32x2 __attribute__((ext_vector_type(2)));
typedef unsigned u32x4 __attribute__((ext_vector_type(4)));
typedef unsigned u32x2 __attribute__((ext_vector_type(2)));

constexpr size_t WS_WIN = WS_W;
constexpr size_t WS_W13 = WS_W + 10 * MiB;
constexpr size_t WS_W2 = WS_W + 74 * MiB;
constexpr size_t WS_WPG = WS_W + 106 * MiB;
constexpr size_t WS_WOUT = WS_W + 108 * MiB;
constexpr size_t WS_WUA = WS_W + 110 * MiB;
constexpr size_t WS_WUB = WS_W + 111 * MiB;
constexpr size_t WS_WPLE = WS_W + 112 * MiB;
constexpr size_t WS_WSP = WS_W + 112 * MiB + 512 * 1024;
constexpr size_t WS_WR = WS_W + 112 * MiB + 768 * 1024;
constexpr size_t WS_LB = WS_W + 112 * MiB + 896 * 1024;
constexpr size_t WS_P16 = WS_Z + 256 * MiB;
constexpr size_t WS_CTL = WS_MISC + 5 * MiB + 4096;
static_assert(WS_LB + 2048 <= WS_MISC, "weight map");

__device__ __forceinline__ float fsig(float v) { return __builtin_amdgcn_rcpf(1.f + __builtin_amdgcn_exp2f(-1.4426950408889634f * v)); }
__device__ __forceinline__ float fgelu(float v) { return v * fsig(1.5957691216057308f * (v + 0.044715f * v * v * v)); }
__device__ __forceinline__ unsigned pkh(float a, float b) { h16x2 t; t.x = (h16)a; t.y = (h16)b; return __builtin_bit_cast(unsigned, t); }
__device__ __forceinline__ u32x4 pk8(f32x4 a, f32x4 b) { u32x4 w; w.x = pkh(a[0], a[1]); w.y = pkh(a[2], a[3]); w.z = pkh(b[0], b[1]); w.w = pkh(b[2], b[3]); return w; }
__device__ __forceinline__ void unpk8(u32x4 w, f32x4& a, f32x4& b) {
    const h16x8 t = __builtin_bit_cast(h16x8, w);
    a = (f32x4){(float)t[0], (float)t[1], (float)t[2], (float)t[3]}; b = (f32x4){(float)t[4], (float)t[5], (float)t[6], (float)t[7]}; }

namespace g8 {
constexpr int BM = 256, BK = 64, HALF = 128, HTB = HALF * BK * 2, STAGE_BYTES = 8 * HTB, NXCD = 8, WGM = 8;
__device__ __forceinline__ int lds_byte(int r, int c) { const int st = (r >> 4) * 2 + (c >> 5), rr = r & 15, cc = c & 31, ob = rr * 64 + cc * 2; return st * 1024 + (ob ^ (((ob >> 9) & 1) << 5)); }
__device__ __forceinline__ void stage_rc(int b, int& R, int& C) { const int st = b / 1024, sb = b % 1024, swz = sb ^ (((sb >> 9) & 1) << 5); R = (st >> 1) * 16 + swz / 64; C = (st & 1) * 32 + (swz % 64) / 2; }
__device__ __forceinline__ int perm32(int rho) { const int n = rho >> 4, i = rho & 15; return 8 * (i >> 2) + 4 * n + (i & 3); }
struct Tile { int pm, pn; };
struct StaticOrder {
    int nM, nN, nwg, G, c;
    __device__ void init(int nM_, int nN_, int G_, int c_) { nM = nM_; nN = nN_; nwg = nM * nN; G = G_; c = c_; }
    __device__ bool next(int i, Tile& u) const {
        const long L = (long)i * G + c; if (L >= nwg) return false;
        int wgid = (int)L; { const int q = nwg / NXCD, r = nwg % NXCD, xcd = wgid % NXCD, off = wgid / NXCD; wgid = (xcd < r ? xcd * (q + 1) : r * (q + 1) + (xcd - r) * q) + off; }
        const int nig = WGM * nN, gid = wgid / nig, fm = gid * WGM, gsz = (nM - fm) < WGM ? (nM - fm) : WGM;
        u.pm = fm + ((wgid % nig) % gsz); u.pn = (wgid % nig) / gsz; return true;
    }
};
template <class PH>
__device__ __forceinline__ void gemm_phase(LAS unsigned char* lds, const PH& ph) {
    const int tid = threadIdx.x, wid = __builtin_amdgcn_readfirstlane(tid >> 6), lane = tid & 63, wr = wid >> 2, wc = wid & 3, fr = lane & 15, fq = lane >> 4;
    constexpr int nt = PH::KT;
    int R[2], C[2]; unsigned voffB[2], voffA[2];
#pragma unroll
    for (int i = 0; i < 2; ++i) { stage_rc(tid * 16 + i * 8192, R[i], C[i]); const int Rb = PH::PERM ? ((R[i] & ~31) + perm32(R[i] & 31)) : R[i]; voffB[i] = (unsigned)(Rb * PH::LDB + C[i] * 2); voffA[i] = (unsigned)(R[i] * PH::LDA + C[i] * 2); }
    constexpr size_t kstep = BK * 2, hstepB = (size_t)HALF * PH::LDB, hstepA = PH::GATHER ? 0 : (size_t)HALF * PH::LDA;
    const unsigned ldsw = (unsigned)wid * 1024u;
    const int aoff = lds_byte(wr * 64 + fr, fq * 8), boff = lds_byte(wc * 32 + fr, fq * 8);
#define G8_SA(b, h) (((b) * 2 + (h)) * HTB)
#define G8_SB(b, h) ((4 + (b) * 2 + (h)) * HTB)
#define G8_STG(bufoff, gptr, o0, o1) do { \
        __builtin_amdgcn_global_load_lds((const unsigned*)((gptr) + (o0)), (LAS unsigned*)(lds + (bufoff) + ldsw), 16, 0, 0); \
        __builtin_amdgcn_global_load_lds((const unsigned*)((gptr) + (o1)), (LAS unsigned*)(lds + (bufoff) + ldsw + 8192), 16, 0, 0); } while (0)
#define G8_STGB(bufoff, gptr) G8_STG(bufoff, gptr, voffB[0], voffB[1])
#define G8_STGA(bufoff, gptr, h, useN) do { if constexpr (PH::GATHER) { G8_STG(bufoff, gptr, ((useN) ? na[h][0] : ca[h][0]), ((useN) ? na[h][1] : ca[h][1])); } \
        else { G8_STG(bufoff, (gptr) + (h) * hstepA, voffA[0], voffA[1]); } } while (0)
#define G8_LDA(dst, b, h) do { _Pragma("unroll") for (int m = 0; m < 4; ++m) _Pragma("unroll") for (int k = 0; k < 2; ++k) dst[m][k] = *(const LAS h16x8*)(lds + G8_SA(b, h) + aoff + m * 2048 + k * 1024); } while (0)
#define G8_LDB(dst, b, h) do { _Pragma("unroll") for (int n = 0; n < 2; ++n) _Pragma("unroll") for (int k = 0; k < 2; ++k) dst[n][k] = *(const LAS h16x8*)(lds + G8_SB(b, h) + boff + n * 2048 + k * 1024); } while (0)
#define G8_MMA(ai, bj, At, Bt) do { __builtin_amdgcn_s_setprio(1); _Pragma("unroll") for (int m = 0; m < 4; ++m) _Pragma("unroll") for (int n = 0; n < 2; ++n) _Pragma("unroll") for (int k = 0; k < 2; ++k) \
        acc[ai][bj][m][n] = __builtin_amdgcn_mfma_f32_16x16x32_f16(Bt[n][k], At[m][k], acc[ai][bj][m][n], 0, 0, 0); __builtin_amdgcn_s_setprio(0); } while (0)
#define G8_WAIT_V(n) asm volatile("s_waitcnt vmcnt(" #n ")" ::: "memory")
#define G8_WAIT_L(n) asm volatile("s_waitcnt lgkmcnt(" #n ")" ::: "memory")
#define G8_BAR __builtin_amdgcn_s_barrier()
#define G8_SCHED __builtin_amdgcn_sched_barrier(0)
    typename PH::Unit cur, nxt; int ui = 0;
    if (!ph.next(0, cur)) return;
    f32x4 acc[2][2][4][2];
#pragma unroll
    for (int a = 0; a < 2; ++a)
#pragma unroll
        for (int b = 0; b < 2; ++b)
#pragma unroll
            for (int m = 0; m < 4; ++m)
#pragma unroll
                for (int n = 0; n < 2; ++n) acc[a][b][m][n] = (f32x4){0.f, 0.f, 0.f, 0.f};
    h16x8 At[4][2], B0[2][2], B1[2][2];
    unsigned ca[2][2], na[2][2];
    if constexpr (PH::GATHER) ph.a_off(cur, R, C, ca);
    const char* cA = ph.a_ptr(cur); const char* cB = ph.b_ptr(cur);
    G8_STGB(G8_SB(0, 0), cB); G8_STGB(G8_SB(0, 1), cB + hstepB); G8_STGA(G8_SA(0, 0), cA, 0, false); G8_STGA(G8_SA(0, 1), cA, 1, false);
    if (wr == 1) G8_BAR;
    G8_WAIT_V(2); G8_BAR;
    G8_STGB(G8_SB(1, 0), cB + kstep); G8_STGA(G8_SA(1, 0), cA + kstep, 0, false); G8_STGB(G8_SB(1, 1), cB + hstepB + kstep);
    G8_WAIT_V(6); G8_BAR;
    for (;;) {
        const bool has_next = ph.next(ui + 1, nxt);
        const char* nA; const char* nB;
        if (has_next) { if constexpr (PH::GATHER) ph.a_off(nxt, R, C, na); nA = ph.a_ptr(nxt); nB = ph.b_ptr(nxt); }
        else { if constexpr (PH::GATHER) { na[0][0] = ca[0][0]; na[0][1] = ca[0][1]; na[1][0] = ca[1][0]; na[1][1] = ca[1][1]; } nA = cA; nB = cB; }
#pragma unroll 1
        for (int t = 0; t < nt; t += 2) {
            const bool last = (t == nt - 2);
            const char* a1 = cA + (size_t)(t + 1) * kstep;
            const char* a2 = last ? nA : cA + (size_t)(t + 2) * kstep; const char* b2 = last ? nB : cB + (size_t)(t + 2) * kstep;
            const char* a3 = a2 + kstep; const char* b3 = b2 + kstep;
            G8_LDB(B0, 0, 0); G8_LDB(B1, 0, 1); G8_SCHED; G8_LDA(At, 0, 0); G8_STGA(G8_SA(1, 1), a1, 1, false);
            G8_WAIT_V(8); G8_WAIT_L(0); G8_BAR; G8_MMA(0, 0, At, B0); G8_MMA(0, 1, At, B1); G8_BAR; G8_SCHED;
            G8_LDA(At, 0, 1); G8_STGB(G8_SB(0, 0), b2); G8_STGB(G8_SB(0, 1), b2 + hstepB); G8_STGA(G8_SA(0, 0), a2, 0, last);
            G8_WAIT_V(8); G8_WAIT_L(0); G8_BAR; G8_MMA(1, 0, At, B0); G8_MMA(1, 1, At, B1); G8_BAR; G8_SCHED;
            G8_LDB(B0, 1, 0); G8_LDB(B1, 1, 1); G8_SCHED; G8_LDA(At, 1, 0); G8_STGA(G8_SA(0, 1), a2, 1, last);
            G8_WAIT_V(8); G8_WAIT_L(0); G8_BAR; G8_MMA(0, 0, At, B0); G8_MMA(0, 1, At, B1); G8_BAR; G8_SCHED;
            G8_LDA(At, 1, 1); G8_STGB(G8_SB(1, 0), b3); G8_STGB(G8_SB(1, 1), b3 + hstepB); G8_STGA(G8_SA(1, 0), a3, 0, last);
            G8_WAIT_V(8); G8_WAIT_L(0); G8_BAR; G8_MMA(1, 0, At, B0); G8_MMA(1, 1, At, B1); G8_BAR; G8_SCHED;
        }
        if (wr == 0) G8_BAR;
        const bool keep = ph.epi(acc, cur, wr, wc, fr, fq);
        if (!has_next) break;
        if (!keep) {
#pragma unroll
            for (int a = 0; a < 2; ++a)
#pragma unroll
                for (int b = 0; b < 2; ++b)
#pragma unroll
                    for (int m = 0; m < 4; ++m)
#pragma unroll
                        for (int n = 0; n < 2; ++n) acc[a][b][m][n] = (f32x4){0.f, 0.f, 0.f, 0.f};
        }
        cur = nxt; cA = nA; cB = nB; if constexpr (PH::GATHER) { ca[0][0] = na[0][0]; ca[0][1] = na[0][1]; ca[1][0] = na[1][0]; ca[1][1] = na[1][1]; } ++ui;
        if (wr == 1) G8_BAR;
    }
    G8_WAIT_V(0);
    G8_BAR;
#undef G8_SA
#undef G8_SB
#undef G8_STG
#undef G8_STGB
#undef G8_STGA
#undef G8_LDA
#undef G8_LDB
#undef G8_MMA
#undef G8_WAIT_V
#undef G8_WAIT_L
#undef G8_BAR
#undef G8_SCHED
}
}

#define XB_TMO      128
#define XB_XCNT(j)  (256  + 64 * (j))
#define XB_XSUB(j)  (1280 + 64 * (j))
#define XB_XGEN(j)  (2304 + 64 * (j))
#define XB_TOP      3328
#define XB_TOPGEN   3392
#define XCD_BAR_WORDS 3456
#define XB_SPIN_CAP (1u << 18)
__device__ __forceinline__ unsigned xb_ld(unsigned* p)              { return __hip_atomic_load(p, __ATOMIC_RELAXED, __HIP_MEMORY_SCOPE_AGENT); }
__device__ __forceinline__ unsigned xb_add(unsigned* p, unsigned v) { return __hip_atomic_fetch_add(p, v, __ATOMIC_RELAXED, __HIP_MEMORY_SCOPE_AGENT); }
__device__ __forceinline__ unsigned xb_xcc_id() { return (unsigned)__builtin_amdgcn_s_getreg((3 << 11) | 20) & 0xFu; }
#define XB_SPIN(cond, bar) do { unsigned _sp = 0; while (cond) { __builtin_amdgcn_s_sleep(1); \
    if ((++_sp & 255u) == 0u) { if (xb_ld(&(bar)[XB_TMO])) break; if (_sp > XB_SPIN_CAP) { atomicAdd(&(bar)[XB_TMO], 1u); break; } } } } while (0)
struct XcdBarrier { unsigned* bar; unsigned x; volatile LAS unsigned* st; };
__device__ __forceinline__ XcdBarrier xcd_barrier_post(unsigned* bar, volatile LAS unsigned* st) {
    XcdBarrier b; b.bar = bar; b.x = xb_xcc_id(); b.st = st;
    if (threadIdx.x == 0) (void)xb_add(&bar[XB_XCNT(b.x)], 1u);
    return b;
}
__device__ __forceinline__ void xcd_barrier_complete(unsigned* bar, unsigned x, unsigned& nloc, unsigned& nx) {
    const unsigned G = gridDim.x * gridDim.y * gridDim.z;
    unsigned sum, cnt, mine, sp = 0u;
    for (;;) {
        sum = 0u; cnt = 0u; mine = 0u;
#pragma unroll
        for (unsigned j = 0; j < 16; ++j) { const unsigned c = xb_ld(&bar[XB_XCNT(j)]); sum += c; cnt += (c > 0u) ? 1u : 0u; mine = (j == x) ? c : mine; }
        if (sum == G) break;
        __builtin_amdgcn_s_sleep(1);
        if ((++sp & 255u) == 0u) { if (xb_ld(&bar[XB_TMO])) break; if (sp > XB_SPIN_CAP) { atomicAdd(&bar[XB_TMO], 1u); break; } }
    }
    nloc = mine > 0u ? mine : 1u; nx = cnt > 0u ? cnt : 1u;
}
__device__ __forceinline__ void xcd_barrier(const XcdBarrier& b) {
    asm volatile("s_waitcnt vmcnt(0)" ::: "memory");
    __syncthreads();
    if (threadIdx.x == 0) {
        unsigned* bar = b.bar;
        __builtin_amdgcn_s_waitcnt(0);
        unsigned nloc = b.st[0], nx = b.st[1];
        if (nloc == 0u) { xcd_barrier_complete(bar, b.x, nloc, nx); b.st[0] = nloc; b.st[1] = nx; }
        const unsigned old = xb_add(&bar[XB_XSUB(b.x)], 1u);
        const unsigned gen = old / nloc;
        if (old + 1u == (gen + 1u) * nloc) {
            __builtin_amdgcn_fence(__ATOMIC_RELEASE, "agent");
            asm volatile("s_waitcnt vmcnt(0)" ::: "memory");
            const unsigned og = xb_add(&bar[XB_TOP], 1u);
            const unsigned tg = og / nx;
            if (og + 1u == (tg + 1u) * nx) xb_add(&bar[XB_TOPGEN], 1u);
            else XB_SPIN(xb_ld(&bar[XB_TOPGEN]) == tg, bar);
            __builtin_amdgcn_fence(__ATOMIC_ACQUIRE, "agent");
            xb_add(&bar[XB_XGEN(b.x)], 1u);
            asm volatile("s_waitcnt vmcnt(0)" ::: "memory");
        } else {
            XB_SPIN(xb_ld(&bar[XB_XGEN(b.x)]) == gen, bar);
            __builtin_amdgcn_fence(__ATOMIC_ACQUIRE, "agent");
            asm volatile("s_waitcnt vmcnt(0)" ::: "memory");
        }
    }
    __syncthreads();
}

constexpr int RING_BYTES = 131072;
constexpr int LDS_BYTES = 147456;
constexpr int MISC_OFF = LDS_BYTES - 128;
constexpr int NWAVES = 8;

struct Frame { LAS unsigned char* lds; int tid, lane, wave, G, vcu; P p; };

__device__ __forceinline__ void p0_item(const float* W, int ldw, h16* WT, int ldt, int drow0, int k0, int n0, LAS float* scr, int lane) {
#pragma unroll 8
    for (int i = 0; i < 32; ++i) { const int kk = 2 * i + (lane >> 5); scr[kk * 33 + (lane & 31)] = W[(size_t)(k0 + kk) * ldw + n0 + (lane & 31)]; }
    asm volatile("s_waitcnt lgkmcnt(0)" ::: "memory");
    const int c = lane & 7;
#pragma unroll
    for (int j = 0; j < 4; ++j) { const int n = (lane >> 3) + 8 * j; const LAS float* s = scr + (8 * c) * 33 + n;
        u32x4 o; o.x = pkh(s[0 * 33], s[1 * 33]); o.y = pkh(s[2 * 33], s[3 * 33]); o.z = pkh(s[4 * 33], s[5 * 33]); o.w = pkh(s[6 * 33], s[7 * 33]);
        *(u32x4*)(WT + (size_t)(drow0 + n) * ldt + k0 + 8 * c) = o; }
    asm volatile("s_waitcnt lgkmcnt(0)" ::: "memory");
}
__device__ __forceinline__ void rms_row_h16(const float* xrow, const float* g, h16* orow, int lane) {
    const f32x4* xr = (const f32x4*)xrow + lane; f32x4 v[4]; float s = 0.f;
#pragma unroll
    for (int j = 0; j < 4; ++j) { v[j] = xr[64 * j]; s += (v[j].x * v[j].x + v[j].y * v[j].y) + (v[j].z * v[j].z + v[j].w * v[j].w); }
    const float r = rsqrtf(wave_sum(s) * (1.f / D) + EPS);
    u32x2* o8 = (u32x2*)orow + lane;
#pragma unroll
    for (int j = 0; j < 4; ++j) { const f32x4 gg = ((const f32x4*)g)[lane + 64 * j]; u32x2 w; w.x = pkh(v[j].x * r * gg.x, v[j].y * r * gg.y); w.y = pkh(v[j].z * r * gg.z, v[j].w * r * gg.w); o8[64 * j] = w; }
}
__device__ __forceinline__ void p0_prologue(Frame& F) {
    const P& p = F.p; unsigned char* ws = p.ws;
    LAS float* scr = (LAS float*)(F.lds + F.wave * 16384);
    const int gw = F.vcu * NWAVES + F.wave, NGW = F.G * NWAVES;
    constexpr int I_IN = 16 * 160, I_UA = 8 * 32, I_OUT = 16 * 32, I_PLE = 4 * 32, I_E13 = 16 * 16, I_E2 = 8 * 32;
    constexpr int NITEMS = I_IN + 2 * I_UA + 2 * I_OUT + I_PLE + NE * (2 * I_E13 + I_E2);
    for (int it = gw; it < NITEMS; it += NGW) {
        int r = it;
        if (r < I_IN) { const int kb = r / 160, nb = r % 160; p0_item(p.w_in, INC, (h16*)(ws + WS_WIN), D, nb * 32, kb * 64, nb * 32, scr, F.lane); continue; } r -= I_IN;
        if (r < I_UA) { const int kb = r / 32, nb = r % 32; p0_item(p.w_up_a, D, (h16*)(ws + WS_WUA), 512, nb * 32, kb * 64, nb * 32, scr, F.lane); continue; } r -= I_UA;
        if (r < I_UA) { const int kb = r / 32, nb = r % 32; p0_item(p.w_up_b, D, (h16*)(ws + WS_WUB), 512, nb * 32, kb * 64, nb * 32, scr, F.lane); continue; } r -= I_UA;
        if (r < I_OUT) { const int kb = r / 32, nb = r % 32; p0_item(p.w_out, D, (h16*)(ws + WS_WOUT), D, nb * 32, kb * 64, nb * 32, scr, F.lane); continue; } r -= I_OUT;
        if (r < I_OUT) { const int kb = r / 32, nb = r % 32; p0_item(p.w_pg, D, (h16*)(ws + WS_WPG), D, nb * 32, kb * 64, nb * 32, scr, F.lane); continue; } r -= I_OUT;
        if (r < I_PLE) { const int kb = r / 32, nb = r % 32; p0_item(p.w_ple, D, (h16*)(ws + WS_WPLE), PLE, nb * 32, kb * 64, nb * 32, scr, F.lane); continue; } r -= I_PLE;
        const int e = r / (2 * I_E13 + I_E2); r -= e * (2 * I_E13 + I_E2);
        if (r < 2 * I_E13) { const int which = r / I_E13; r -= which * I_E13; const int kb = r / 16, nb = r % 16, n0 = nb * 32;
            const int drow = (n0 >> 7) * 256 + which * 128 + (n0 & 127);
            p0_item((which ? p.w3 : p.w1) + (size_t)e * D * DE, DE, (h16*)(ws + WS_W13) + (size_t)e * D * D, D, drow, kb * 64, n0, scr, F.lane); continue; }
        r -= 2 * I_E13;
        { const int kb = r / 32, nb = r % 32; p0_item(p.w2 + (size_t)e * DE * D, D, (h16*)(ws + WS_W2) + (size_t)e * D * DE, DE, nb * 32, kb * 64, nb * 32, scr, F.lane); }
    }
    const int gt = F.vcu * 512 + F.tid, NGT = F.G * 512;
    for (int i = gt; i < 48 * 1024; i += NGT) { const int n = i >> 10, k = i & 1023; float v = 0.f;
        if (n < 4) v = p.w_grp[k * 4 + n] * p.g_ffn[k]; else if (n < 36) v = p.w_exp[k * 32 + (n - 4)] * p.g_ffn[k];
        ((h16*)(ws + WS_WR))[i] = (h16)v; }
    for (int i = gt; i < 8 * 128 * 128; i += NGT) { const int t = (i >> 7) & 127, s = i & 127; ((h16*)(ws + WS_WSP))[i] = (h16)(s <= t ? p.gm_w_sp[i] : 0.f); }
    for (int i = gt; i < 512; i += NGT) ((float*)(ws + WS_LB))[i] = 1.f / (1.f + expf(p.hg_lb[512 + i] - p.hg_lb[i]));
    for (int m = gw; m < T; m += NGW) rms_row_h16(p.x + (size_t)m * D, p.g_mix, (h16*)(ws + WS_HB) + (size_t)m * D, F.lane);
}

struct PhIn {
    static constexpr int KT = 16, LDA = 2048, LDB = 2048; static constexpr bool PERM = true, GATHER = false;
    using Unit = g8::Tile;
    g8::StaticOrder S; unsigned char* ws; int noepi;
    __device__ __forceinline__ bool next(int i, Unit& u) const { return S.next(i, u); }
    __device__ __forceinline__ const char* a_ptr(const Unit& u) const { return (const char*)(ws + WS_HB) + (size_t)u.pm * 256 * LDA; }
    __device__ __forceinline__ const char* b_ptr(const Unit& u) const { return (const char*)(ws + WS_WIN) + (size_t)u.pn * 256 * LDB; }
    __device__ __forceinline__ void a_off(const Unit&, const int (&)[2], const int (&)[2], unsigned (&)[2][2]) const {}
    template <int MODE> __device__ __forceinline__ void store_tile(const f32x4 (&acc)[2][2][4][2], h16* base, int ld, int row0, int col0, int lbc0) const {
        f32x4 l0[2], l1[2];
        if (MODE == 2) {
#pragma unroll
            for (int bj = 0; bj < 2; ++bj) { l0[bj] = *(const f32x4*)((const float*)(ws + WS_LB) + lbc0 + bj * 128); l1[bj] = *(const f32x4*)((const float*)(ws + WS_LB) + lbc0 + bj * 128 + 4); }
        }
#pragma unroll
        for (int ai = 0; ai < 2; ++ai)
#pragma unroll
            for (int m = 0; m < 4; ++m) { h16* rowp = base + (size_t)(row0 + ai * 128 + m * 16) * ld + col0;
#pragma unroll
                for (int bj = 0; bj < 2; ++bj) { f32x4 v0 = acc[ai][bj][m][0], v1 = acc[ai][bj][m][1];
#pragma unroll
                    for (int j = 0; j < 4; ++j) {
                        if (MODE == 0) { v0[j] = fgelu(v0[j]); v1[j] = fgelu(v1[j]); }
                        if (MODE == 1) { v0[j] = v0[j] * fsig(v0[j]); v1[j] = v1[j] * fsig(v1[j]); }
                        if (MODE == 2) { const float a = l0[bj][j], b = l1[bj][j];
                            v0[j] = 0.6931471805599453f * __builtin_amdgcn_logf(a + (1.f - a) * fsig(v0[j])); v1[j] = 0.6931471805599453f * __builtin_amdgcn_logf(b + (1.f - b) * fsig(v1[j])); }
                        if (MODE == 4) { v0[j] = fsig(v0[j]); v1[j] = fsig(v1[j]); }
                    }
                    *(u32x4*)(rowp + bj * 128) = pk8(v0, v1); } }
    }
    __device__ __forceinline__ bool epi(const f32x4 (&acc)[2][2][4][2], const Unit& u, int wr, int wc, int fr, int fq) const {
        if (noepi) {
#pragma unroll
            for (int a = 0; a < 2; ++a)
#pragma unroll
                for (int b = 0; b < 2; ++b)
#pragma unroll
                    for (int m = 0; m < 4; ++m) asm volatile("" :: "v"(acc[a][b][m][0]), "v"(acc[a][b][m][1]));
            return false; }
        const int pn = u.pn, row0 = u.pm * 256 + wr * 64 + fr, cl = wc * 32 + 8 * fq;
        if (pn < 12) { h16* base = (h16*)(ws + WS_UB + (size_t)(pn >> 1) * 32 * MiB); const int col0 = (pn & 1) * 256 + cl;
            if (pn < 4) store_tile<0>(acc, base, 512, row0, col0, 0);
            else if (pn < 6) store_tile<1>(acc, base, 512, row0, col0, 0);
            else if (pn < 8) store_tile<2>(acc, base, 512, row0, col0, col0);
            else store_tile<3>(acc, base, 512, row0, col0, 0);
        } else { h16* base = (h16*)(ws + (pn < 16 ? WS_GA : WS_GB)); store_tile<4>(acc, base, 1024, row0, ((pn - 12) & 3) * 256 + cl, 0); }
        return false;
    }
};

constexpr int WRS = 2064;
constexpr int RT_SCR = 100352;
__device__ __forceinline__ void route_phase(Frame& F) {
    const P& p = F.p; unsigned char* ws = p.ws; const int lane = F.lane, fr = lane & 15, fq = lane >> 4;
    for (int i = F.tid; i < 48 * 128; i += 512) { const int n = i >> 7, c = i & 127; *(LAS u32x4*)(F.lds + n * WRS + c * 16) = *(const u32x4*)(ws + WS_WR + (size_t)n * 2048 + c * 16); }
    LAS float* scr = (LAS float*)(F.lds + RT_SCR + F.wave * 3200);
    LAS int* hist = (LAS int*)(F.lds + RT_SCR + 8 * 3200);
    for (int tile = F.vcu * 8 + F.wave; tile < T / 16; tile += F.G * 8) {
        if (F.tid < 64) hist[F.tid] = 0;
        __syncthreads();
        const int row = tile * 16 + fr;
        const float* xr = p.out + (size_t)row * D + fq * 8;
        h16x8 af[32]; float ss = 0.f; f32x4 acc[3] = {{0.f, 0.f, 0.f, 0.f}, {0.f, 0.f, 0.f, 0.f}, {0.f, 0.f, 0.f, 0.f}};
#pragma unroll
        for (int ks = 0; ks < 32; ++ks) {
            const f32x4 v0 = *(const f32x4*)(xr + ks * 32), v1 = *(const f32x4*)(xr + ks * 32 + 4);
            ss += (v0.x * v0.x + v0.y * v0.y) + (v0.z * v0.z + v0.w * v0.w) + (v1.x * v1.x + v1.y * v1.y) + (v1.z * v1.z + v1.w * v1.w);
            af[ks] = __builtin_bit_cast(h16x8, pk8(v0, v1));
#pragma unroll
            for (int nt = 0; nt < 3; ++nt) { const h16x8 bf = *(const LAS h16x8*)(F.lds + (16 * nt + fr) * WRS + ks * 64 + fq * 16);
                acc[nt] = __builtin_amdgcn_mfma_f32_16x16x32_f16(af[ks], bf, acc[nt], 0, 0, 0); }
        }
        ss += __shfl_xor(ss, 16); ss += __shfl_xor(ss, 32);
        const float rstd = rsqrtf(ss * (1.f / D) + EPS);
#pragma unroll
        for (int nt = 0; nt < 3; ++nt)
#pragma unroll
            for (int r = 0; r < 4; ++r) scr[(4 * fq + r) * 48 + 16 * nt + fr] = acc[nt][r];
        if (lane < 16) scr[16 * 48 + lane] = rstd;
        h16* hb = (h16*)(ws + WS_HB) + (size_t)row * D + fq * 8;
#pragma unroll
        for (int ks = 0; ks < 32; ++ks) { f32x4 a, b; unpk8(__builtin_bit_cast(u32x4, af[ks]), a, b);
            const f32x4 g0 = *(const f32x4*)(p.g_ffn + ks * 32 + fq * 8), g1 = *(const f32x4*)(p.g_ffn + ks * 32 + fq * 8 + 4);
            *(u32x4*)(hb + ks * 32) = pk8(a * g0 * rstd, b * g1 * rstd); }
        asm volatile("s_waitcnt lgkmcnt(0)" ::: "memory");
        int E0 = 0, E1 = 0, p0 = 0, p1 = 0; float g0 = 0.f, g1 = 0.f;
        if (lane < 16) {
            const float rs = scr[16 * 48 + lane]; const LAS float* lg = scr + lane * 48;
            int gs = 0; float best = lg[0];
#pragma unroll
            for (int n = 1; n < 4; ++n) { const float v = lg[n]; if (v > best) { best = v; gs = n; } }
            float den = 0.f;
#pragma unroll
            for (int n = 0; n < 4; ++n) den += expf((lg[n] - best) * rs);
            const float pg = 1.f / den;
            const LAS float* le = lg + 4 + gs * 8;
            int e0 = 0; float l0 = le[0];
#pragma unroll
            for (int n = 1; n < 8; ++n) { const float v = le[n]; if (v > l0) { l0 = v; e0 = n; } }
            int e1 = -1; float l1 = -3.0e38f;
#pragma unroll
            for (int n = 0; n < 8; ++n) { const float v = le[n]; if (n != e0 && v > l1) { l1 = v; e1 = n; } }
            const float w1 = expf((l1 - l0) * rs);
            g0 = pg / (1.f + w1); g1 = pg * w1 / (1.f + w1);
            E0 = gs * 8 + e0; E1 = gs * 8 + e1;
            p0 = atomicAdd((int*)hist + E0, 1); p1 = atomicAdd((int*)hist + E1, 1);
        }
        __syncthreads();
        if (F.tid < 32) { const int c = hist[F.tid]; hist[32 + F.tid] = c ? atomicAdd((int*)(ws + WS_CNT) + F.tid, c) : 0; }
        __syncthreads();
        if (lane < 16) { int* list = (int*)(ws + WS_LIST); float* gate = (float*)(ws + WS_GATE);
            list[(size_t)E0 * ECAP + hist[32 + E0] + p0] = 2 * row; gate[2 * row] = g0;
            list[(size_t)E1 * ECAP + hist[32 + E1] + p1] = 2 * row + 1; gate[2 * row + 1] = g1; }
        __syncthreads();
    }
    for (size_t i = ((size_t)F.vcu * 512 + F.tid) * 4; i < (size_t)T * PLE; i += (size_t)F.G * 512 * 4) { const f32x4 v = *(const f32x4*)(p.p + i); u32x2 w; w.x = pkh(v.x, v.y); w.y = pkh(v.z, v.w); *(u32x2*)((h16*)(ws + WS_P16) + i) = w; }
}

struct UnitMoe { int e, rt, pn, cnt; };
struct MoeOrder {
    int cnt[4], nt[4], j, x;
    __device__ void init(const int* gcnt, int bx) { x = bx & 7; j = bx >> 3;
#pragma unroll
        for (int q = 0; q < 4; ++q) { cnt[q] = gcnt[x + 8 * q]; nt[q] = (cnt[q] + 255) >> 8; } }
    __device__ bool next(int i, UnitMoe& u) const {
        int q = i * 32 + j;
#pragma unroll
        for (int k = 0; k < 4; ++k) { const int nu = nt[k] * 4; if (q < nu) { u.e = x + 8 * k; u.rt = q >> 2; u.pn = q & 3; u.cnt = cnt[k]; return true; } q -= nu; }
        return false;
    }
};
struct PhMup {
    static constexpr int KT = 16, LDA = 2048, LDB = 2048; static constexpr bool PERM = true, GATHER = true;
    using Unit = UnitMoe;
    MoeOrder S; unsigned char* ws;
    __device__ __forceinline__ bool next(int i, Unit& u) const { return S.next(i, u); }
    __device__ __forceinline__ const char* a_ptr(const Unit&) const { return (const char*)(ws + WS_HB); }
    __device__ __forceinline__ const char* b_ptr(const Unit& u) const { return (const char*)(ws + WS_W13) + ((size_t)u.e * 1024 + (size_t)u.pn * 256) * LDB; }
    __device__ __forceinline__ void a_off(const Unit& u, const int (&R)[2], const int (&C)[2], unsigned (&o)[2][2]) const {
        const int* list = (const int*)(ws + WS_LIST) + (size_t)u.e * ECAP;
#pragma unroll
        for (int h = 0; h < 2; ++h)
#pragma unroll
            for (int i = 0; i < 2; ++i) { int r = u.rt * 256 + h * 128 + R[i]; r = r < u.cnt ? r : u.cnt - 1; o[h][i] = (unsigned)((list[r] >> 1) * LDA + C[i] * 2); }
    }
    __device__ __forceinline__ bool epi(const f32x4 (&acc)[2][2][4][2], const Unit& u, int wr, int wc, int fr, int fq) const {
        const int* list = (const int*)(ws + WS_LIST) + (size_t)u.e * ECAP; h16* H = (h16*)(ws + WS_H);
        const int col0 = u.pn * 128 + wc * 32 + 8 * fq;
#pragma unroll
        for (int ai = 0; ai < 2; ++ai)
#pragma unroll
            for (int m = 0; m < 4; ++m) { const int r = u.rt * 256 + ai * 128 + wr * 64 + m * 16 + fr;
                if (r < u.cnt) { const int a = list[r]; f32x4 v0 = acc[ai][0][m][0], v1 = acc[ai][0][m][1];
#pragma unroll
                    for (int j = 0; j < 4; ++j) { v0[j] = v0[j] * fsig(v0[j]) * acc[ai][1][m][0][j]; v1[j] = v1[j] * fsig(v1[j]) * acc[ai][1][m][1][j]; }
                    *(u32x4*)(H + (size_t)a * DE + col0) = pk8(v0, v1); } }
        return false;
    }
};
struct PhMdn {
    static constexpr int KT = 8, LDA = 1024, LDB = 1024; static constexpr bool PERM = true, GATHER = true;
    using Unit = UnitMoe;
    MoeOrder S; unsigned char* ws;
    __device__ __forceinline__ bool next(int i, Unit& u) const { return S.next(i, u); }
    __device__ __forceinline__ const char* a_ptr(const Unit&) const { return (const char*)(ws + WS_H); }
    __device__ __forceinline__ const char* b_ptr(const Unit& u) const { return (const char*)(ws + WS_W2) + ((size_t)u.e * 1024 + (size_t)u.pn * 256) * LDB; }
    __device__ __forceinline__ void a_off(const Unit& u, const int (&R)[2], const int (&C)[2], unsigned (&o)[2][2]) const {
        const int* list = (const int*)(ws + WS_LIST) + (size_t)u.e * ECAP;
#pragma unroll
        for (int h = 0; h < 2; ++h)
#pragma unroll
            for (int i = 0; i < 2; ++i) { int r = u.rt * 256 + h * 128 + R[i]; r = r < u.cnt ? r : u.cnt - 1; o[h][i] = (unsigned)(list[r] * LDA + C[i] * 2); }
    }
    __device__ __forceinline__ bool epi(const f32x4 (&acc)[2][2][4][2], const Unit& u, int wr, int wc, int fr, int fq) const {
        const int* list = (const int*)(ws + WS_LIST) + (size_t)u.e * ECAP; h16* Y = (h16*)(ws + WS_Y); const float* gate = (const float*)(ws + WS_GATE);
        const int col0 = u.pn * 256 + wc * 32 + 8 * fq;
#pragma unroll
        for (int ai = 0; ai < 2; ++ai)
#pragma unroll
            for (int m = 0; m < 4; ++m) { const int r = u.rt * 256 + ai * 128 + wr * 64 + m * 16 + fr;
                if (r < u.cnt) { const int a = list[r]; const float g = gate[a];
#pragma unroll
                    for (int bj = 0; bj < 2; ++bj) *(u32x4*)(Y + (size_t)a * D + col0 + bj * 128) = pk8(acc[ai][bj][m][0] * g, acc[ai][bj][m][1] * g); } }
        return false;
    }
};
__device__ __forceinline__ void combine_phase(Frame& F) {
    const P& p = F.p; unsigned char* ws = p.ws; const int lane = F.lane;
    for (int m = F.vcu * NWAVES + F.wave; m < T; m += F.G * NWAVES) {
        f32x4* xr = (f32x4*)(p.out + (size_t)m * D) + lane; const u32x2* y0 = (const u32x2*)((const h16*)(ws + WS_Y) + (size_t)(2 * m) * D) + lane;
        f32x4 v[4]; float s = 0.f;
#pragma unroll
        for (int j = 0; j < 4; ++j) { v[j] = xr[64 * j]; const u32x2 a = y0[64 * j], b = y0[256 + 64 * j];
            const h16x4 ha = __builtin_bit_cast(h16x4, a), hb = __builtin_bit_cast(h16x4, b);
            v[j].x += (float)ha[0] + (float)hb[0]; v[j].y += (float)ha[1] + (float)hb[1]; v[j].z += (float)ha[2] + (float)hb[2]; v[j].w += (float)ha[3] + (float)hb[3];
            xr[64 * j] = v[j]; s += (v[j].x * v[j].x + v[j].y * v[j].y) + (v[j].z * v[j].z + v[j].w * v[j].w); }
        const float r = rsqrtf(wave_sum(s) * (1.f / D) + EPS);
        u32x2* o8 = (u32x2*)((h16*)(ws + WS_HB) + (size_t)m * D) + lane;
#pragma unroll
        for (int j = 0; j < 4; ++j) { const f32x4 gg = ((const f32x4*)p.g_ple)[lane + 64 * j]; u32x2 w; w.x = pkh(v[j].x * r * gg.x, v[j].y * r * gg.y); w.y = pkh(v[j].z * r * gg.z, v[j].w * r * gg.w); o8[64 * j] = w; }
    }
}
__device__ __forceinline__ void final_phase(Frame& F) {
    const P& p = F.p; const int lane = F.lane;
    for (int m = F.vcu * NWAVES + F.wave; m < T; m += F.G * NWAVES) {
        f32x4* xr = (f32x4*)(p.out + (size_t)m * D) + lane; f32x4 v[4]; float s = 0.f;
#pragma unroll
        for (int j = 0; j < 4; ++j) { v[j] = xr[64 * j]; s += (v[j].x * v[j].x + v[j].y * v[j].y) + (v[j].z * v[j].z + v[j].w * v[j].w); }
        const float r = rsqrtf(wave_sum(s) * (1.f / D) + EPS);
#pragma unroll
        for (int j = 0; j < 4; ++j) { const f32x4 gg = ((const f32x4*)p.g_final)[lane + 64 * j]; xr[64 * j] = v[j] * gg * r; }
    }
}

typedef short s16x8 __attribute__((ext_vector_type(8)));
typedef __bf16 bf16x2_t __attribute__((ext_vector_type(2)));
__device__ __forceinline__ unsigned cvt_pk_bf16(float lo, float hi) { const f32x2 v = {lo, hi}; const bf16x2_t r = __builtin_convertvector(v, bf16x2_t); return __builtin_bit_cast(unsigned, r); }
__device__ __forceinline__ unsigned lds_addr(LAS unsigned char* p) { return (unsigned)(size_t)p; }
#define TR2(lo, hi, a0, a1) asm volatile("ds_read_b64_tr_b16 %0, %2\n\tds_read_b64_tr_b16 %1, %3" : "=&v"(lo), "=&v"(hi) : "v"(a0), "v"(a1) : "memory")
#define TRFRAG(T, lo, hi) __builtin_bit_cast(T, (u32x4){(lo).x, (lo).y, (hi).x, (hi).y})

constexpr int GM_RS = 1056;
__device__ __forceinline__ void gmlp_phase(Frame& F) {
    const P& p = F.p; unsigned char* ws = p.ws; const int lane = F.lane, w = F.wave, fr = lane & 15, fq = lane >> 4;
    const f32x4 lg0 = *(const f32x4*)(p.gm_ln_g + 8 * lane), lg1 = *(const f32x4*)(p.gm_ln_g + 8 * lane + 4), lb0 = *(const f32x4*)(p.gm_ln_b + 8 * lane), lb1 = *(const f32x4*)(p.gm_ln_b + 8 * lane + 4);
    for (int tile = F.vcu; tile < T / 128; tile += F.G) {
        const size_t t0 = (size_t)tile * 128;
        const h16* vb = (const h16*)(ws + WS_VB); h16* ub = (h16*)(ws + WS_UB);
        { u32x4 raw[16];
#pragma unroll
          for (int i = 0; i < 16; ++i) raw[i] = *(const u32x4*)(vb + (t0 + w + 8 * i) * 512 + 8 * lane);
#pragma unroll
          for (int i = 0; i < 16; ++i) { const int t = w + 8 * i; f32x4 a, b; unpk8(raw[i], a, b);
            const float mean = wave_sum((a.x + a.y) + (a.z + a.w) + (b.x + b.y) + (b.z + b.w)) * (1.f / 512);
            a = a - mean; b = b - mean;
            const float r = rsqrtf(wave_sum((a.x * a.x + a.y * a.y) + (a.z * a.z + a.w * a.w) + (b.x * b.x + b.y * b.y) + (b.z * b.z + b.w * b.w)) * (1.f / 512) + EPS);
            *(LAS u32x4*)(F.lds + t * GM_RS + lane * 16) = pk8(a * r * lg0 + lb0, b * r * lg1 + lb1); } }
        __syncthreads();
        const int g = w; const h16* Wg = (const h16*)(ws + WS_WSP) + (size_t)g * 128 * 128;
        const unsigned trbase = lds_addr(F.lds) + (8 * fq + (fr >> 2)) * GM_RS + g * 128 + (lane & 3) * 8;
#pragma unroll
        for (int half = 0; half < 2; ++half) {
            f32x4 acc[4][4];
#pragma unroll
            for (int a = 0; a < 4; ++a)
#pragma unroll
                for (int c = 0; c < 4; ++c) acc[a][c] = (f32x4){0.f, 0.f, 0.f, 0.f};
            h16x8 wf[4][4];
#pragma unroll
            for (int ks = 0; ks < 4; ++ks)
#pragma unroll
                for (int m4 = 0; m4 < 4; ++m4) { const int mi = 4 * half + m4; if (mi >= 2 * ks) wf[ks][m4] = *(const h16x8*)(Wg + (16 * mi + fr) * 128 + 32 * ks + 8 * fq); }
#pragma unroll
            for (int ks = 0; ks < 4; ++ks) { if (2 * ks > 4 * half + 3) continue;
                u32x2 lo[4], hi[4];
#pragma unroll
                for (int c = 0; c < 4; ++c) TR2(lo[c], hi[c], trbase + (32 * ks) * GM_RS + c * 32, trbase + (32 * ks + 4) * GM_RS + c * 32);
                asm volatile("s_waitcnt lgkmcnt(0)" : "+v"(lo[0]), "+v"(hi[0]), "+v"(lo[1]), "+v"(hi[1]), "+v"(lo[2]), "+v"(hi[2]), "+v"(lo[3]), "+v"(hi[3]) :: "memory");
                __builtin_amdgcn_sched_barrier(0);
#pragma unroll
                for (int c = 0; c < 4; ++c) { const h16x8 vf = TRFRAG(h16x8, lo[c], hi[c]);
#pragma unroll
                    for (int m4 = 0; m4 < 4; ++m4) { const int mi = 4 * half + m4; if (mi >= 2 * ks) acc[m4][c] = __builtin_amdgcn_mfma_f32_16x16x32_f16(vf, wf[ks][m4], acc[m4][c], 0, 0, 0); } }
            }
            u32x2 ur[4][4]; float bias[4];
#pragma unroll
            for (int m4 = 0; m4 < 4; ++m4) { const int t = 16 * (4 * half + m4) + fr; bias[m4] = p.gm_b_sp[g * 128 + t];
#pragma unroll
                for (int c = 0; c < 4; ++c) ur[m4][c] = *(const u32x2*)(ub + (t0 + t) * 512 + g * 64 + 16 * c + 4 * fq); }
#pragma unroll
            for (int m4 = 0; m4 < 4; ++m4) { const int t = 16 * (4 * half + m4) + fr;
#pragma unroll
                for (int c = 0; c < 4; ++c) { h16* up = ub + (t0 + t) * 512 + g * 64 + 16 * c + 4 * fq; const h16x4 uh = __builtin_bit_cast(h16x4, ur[m4][c]); const float bs = bias[m4];
                    u32x2 o; o.x = pkh((float)uh[0] * (acc[m4][c][0] + bs), (float)uh[1] * (acc[m4][c][1] + bs)); o.y = pkh((float)uh[2] * (acc[m4][c][2] + bs), (float)uh[3] * (acc[m4][c][3] + bs));
                    *(u32x2*)up = o; } }
        }
        __syncthreads();
        const f32x4 n0 = *(const f32x4*)(p.hg_norm_g + 8 * lane), n1 = *(const f32x4*)(p.hg_norm_g + 8 * lane + 4);
#pragma unroll
        for (int bt = 0; bt < 2; ++bt) { u32x4 ro[8], rg[8];
#pragma unroll
            for (int i = 0; i < 8; ++i) { const size_t row = t0 + w + 8 * (8 * bt + i); ro[i] = *(const u32x4*)((const h16*)(ws + WS_IB) + row * 512 + 8 * lane); rg[i] = *(const u32x4*)((const h16*)(ws + WS_OB) + row * 512 + 8 * lane); }
#pragma unroll
            for (int i = 0; i < 8; ++i) { const size_t row = t0 + w + 8 * (8 * bt + i); f32x4 a, b, ga, gb; unpk8(ro[i], a, b); unpk8(rg[i], ga, gb);
                float ss = (a.x * a.x + a.y * a.y) + (a.z * a.z + a.w * a.w) + (b.x * b.x + b.y * b.y) + (b.z * b.z + b.w * b.w);
                ss += __shfl_xor(ss, 1); ss += __shfl_xor(ss, 2); ss += __shfl_xor(ss, 4); ss += __shfl_xor(ss, 8);
                const float r = rsqrtf(ss * (1.f / 128) + EPS);
#pragma unroll
                for (int j = 0; j < 4; ++j) { a[j] = a[j] * r * n0[j] * fsig(ga[j]); b[j] = b[j] * r * n1[j] * fsig(gb[j]); }
                *(u32x4*)((h16*)(ws + WS_QB) + row * 512 + 8 * lane) = pk8(a, b); } }
    }
}

constexpr int HQ_RS = 272, HE_RS = 288, HI_RS = 80, HS_RS = 80, HA_RS = 144;
constexpr int HG_QD = 0, HG_KI = 17408, HG_KE = 34816, HG_I = 53248, HG_S = 58368, HG_ATT = 68608, HG_TOT = 77824, HG_DEC = 79872, HG_RQ = 80384, HG_RF = 97792;
__device__ __forceinline__ void hgrn_phase(Frame& F) {
    const P& p = F.p; unsigned char* ws = p.ws; const int tid = F.tid, lane = F.lane, w = F.wave, fr = lane & 15, fq = lane >> 4;
    constexpr float L2E = 1.4426950408889634f;
    LAS unsigned char* L = F.lds; const unsigned LA = lds_addr(L);
    for (int item = F.vcu; item < 256; item += F.G) {
        const int bh = item >> 2, sl = item & 3, b = bh >> 2, h = bh & 3;
        const int k = tid & 127, tq = tid >> 7;
        h16* ib = (h16*)(ws + WS_IB) + (size_t)b * SEQ * 512 + h * 128 + sl * 32;
        const int is = tid >> 3, iv4 = (tid & 7) * 4;
        f32x4 S0 = {0.f, 0.f, 0.f, 0.f}, S1 = {0.f, 0.f, 0.f, 0.f};
        for (int i = tid; i < 128 * HS_RS / 4; i += 512) ((LAS unsigned*)(L + HG_S))[i] = 0u;
        const h16* qg = (const h16*)(ws + WS_QB) + (size_t)b * SEQ * 512 + h * 128; const h16* fg = (const h16*)(ws + WS_FB) + (size_t)b * SEQ * 512 + h * 128;
        const int pt0 = tid >> 4, pk = (tid & 15) * 8;
        u32x4 pq[2], pf[2]; u32x2 ri;
#pragma unroll
        for (int u = 0; u < 2; ++u) { pq[u] = *(const u32x4*)(qg + (size_t)(pt0 + 32 * u) * 512 + pk); pf[u] = *(const u32x4*)(fg + (size_t)(pt0 + 32 * u) * 512 + pk); }
        ri = *(const u32x2*)(ib + (size_t)is * 512 + iv4);
#pragma unroll
        for (int u = 0; u < 2; ++u) { *(LAS u32x4*)(L + HG_RQ + (pt0 + 32 * u) * HQ_RS + pk * 2) = pq[u]; *(LAS u32x4*)(L + HG_RF + (pt0 + 32 * u) * HQ_RS + pk * 2) = pf[u]; }
        __syncthreads();
        h16x8 Lf[4][2];
#pragma unroll
        for (int mi = 0; mi < 4; ++mi)
#pragma unroll
            for (int ks = 0; ks < 2; ++ks)
#pragma unroll
                for (int j = 0; j < 8; ++j) Lf[mi][ks][j] = (32 * ks + 8 * fq + j <= 16 * mi + fr) ? (h16)1.0f : (h16)0.0f;
        for (int c = 0; c < SEQ / 64; ++c) {
            const h16x4 ih = __builtin_bit_cast(h16x4, ri);
            if (c + 1 < SEQ / 64) {
#pragma unroll
                for (int u = 0; u < 2; ++u) { pq[u] = *(const u32x4*)(qg + ((size_t)(c + 1) * 64 + pt0 + 32 * u) * 512 + pk); pf[u] = *(const u32x4*)(fg + ((size_t)(c + 1) * 64 + pt0 + 32 * u) * 512 + pk); }
                ri = *(const u32x2*)(ib + ((size_t)(c + 1) * 64 + is) * 512 + iv4);
            }
            f32x4 bb[4];
            { u32x2 fl[2], fh[2];
#pragma unroll
              for (int ks = 0; ks < 2; ++ks) TR2(fl[ks], fh[ks], LA + HG_RF + (32 * ks + (8 * fq + (fr >> 2))) * HQ_RS + w * 32 + (lane & 3) * 8, LA + HG_RF + (32 * ks + 4 + (8 * fq + (fr >> 2))) * HQ_RS + w * 32 + (lane & 3) * 8);
              asm volatile("s_waitcnt lgkmcnt(0)" : "+v"(fl[0]), "+v"(fh[0]), "+v"(fl[1]), "+v"(fh[1]) :: "memory");
              __builtin_amdgcn_sched_barrier(0);
#pragma unroll
              for (int mi = 0; mi < 4; ++mi) { bb[mi] = (f32x4){0.f, 0.f, 0.f, 0.f};
#pragma unroll
                  for (int ks = 0; ks < 2; ++ks) if (2 * ks <= mi) bb[mi] = __builtin_amdgcn_mfma_f32_16x16x32_f16(TRFRAG(h16x8, fl[ks], fh[ks]), Lf[mi][ks], bb[mi], 0, 0, 0); } }
            f32x4 EL;
#pragma unroll
            for (int r = 0; r < 4; ++r) EL[r] = __builtin_amdgcn_exp2f(__shfl(bb[3][r], (lane & 48) | 15) * L2E);
            if (fr == 0) *(LAS f32x4*)(L + HG_DEC + (16 * w + 4 * fq) * 4) = EL;
#pragma unroll
            for (int mi = 0; mi < 4; ++mi) { const int t = 16 * mi + fr; const int kb = (16 * w + 4 * fq) * 2;
                const u32x2 rq2 = *(const LAS u32x2*)(L + HG_RQ + t * HQ_RS + kb), rf2 = *(const LAS u32x2*)(L + HG_RF + t * HQ_RS + kb);
                const h16x4 qh = __builtin_bit_cast(h16x4, rq2), fh4 = __builtin_bit_cast(h16x4, rf2);
                float qd[4], ki[4], ke[4];
#pragma unroll
                for (int r = 0; r < 4; ++r) { const float E = __builtin_amdgcn_exp2f(bb[mi][r] * L2E), rE = __builtin_amdgcn_rcpf(E), kf = 1.f - __builtin_amdgcn_exp2f((float)fh4[r] * L2E);
                    qd[r] = (float)qh[r] * E; ki[r] = kf * rE; ke[r] = ki[r] * EL[r]; }
                u32x2 wq, wi, we; wq.x = cvt_pk_bf16(qd[0], qd[1]); wq.y = cvt_pk_bf16(qd[2], qd[3]); wi.x = cvt_pk_bf16(ki[0], ki[1]); wi.y = cvt_pk_bf16(ki[2], ki[3]); we.x = cvt_pk_bf16(ke[0], ke[1]); we.y = cvt_pk_bf16(ke[2], ke[3]);
                *(LAS u32x2*)(L + HG_QD + t * HQ_RS + kb) = wq; *(LAS u32x2*)(L + HG_KI + t * HQ_RS + kb) = wi; *(LAS u32x2*)(L + HG_KE + t * HE_RS + kb) = we; }
            { u32x2 iw; iw.x = cvt_pk_bf16((float)ih[0], (float)ih[1]); iw.y = cvt_pk_bf16((float)ih[2], (float)ih[3]); *(LAS u32x2*)(L + HG_I + is * HI_RS + iv4 * 2) = iw; }
            __syncthreads();
            { const int mi = w >> 1;
#pragma unroll
              for (int nn = 0; nn < 2; ++nn) { const int ni = 2 * (w & 1) + nn; f32x4 at = {0.f, 0.f, 0.f, 0.f};
                if (ni <= mi) {
#pragma unroll
                    for (int ks = 0; ks < 4; ++ks) { const s16x8 qf = *(const LAS s16x8*)(L + HG_QD + (16 * mi + fr) * HQ_RS + 64 * ks + 16 * fq), kf = *(const LAS s16x8*)(L + HG_KI + (16 * ni + fr) * HQ_RS + 64 * ks + 16 * fq);
                        at = __builtin_amdgcn_mfma_f32_16x16x32_bf16(kf, qf, at, 0, 0, 0); }
#pragma unroll
                    for (int r = 0; r < 4; ++r) at[r] = (16 * mi + fr >= 16 * ni + 4 * fq + r) ? at[r] : 0.f;
                }
                u32x2 aw; aw.x = cvt_pk_bf16(at[0], at[1]); aw.y = cvt_pk_bf16(at[2], at[3]);
                *(LAS u32x2*)(L + HG_ATT + (16 * mi + fr) * HA_RS + (16 * ni + 4 * fq) * 2) = aw; } }
            __syncthreads();
            if (c + 1 < SEQ / 64) {
#pragma unroll
                for (int u = 0; u < 2; ++u) { *(LAS u32x4*)(L + HG_RQ + (pt0 + 32 * u) * HQ_RS + pk * 2) = pq[u]; *(LAS u32x4*)(L + HG_RF + (pt0 + 32 * u) * HQ_RS + pk * 2) = pf[u]; } }
            { const int mi = w >> 1, vi = w & 1;
              const unsigned trq = (8 * fq + (fr >> 2)), trp = (lane & 3) * 8;
              u32x2 il[2][2], ih2[2][2], sl_[4], sh_[4], kl[2], kh[2];
#pragma unroll
              for (int ks = 0; ks < 2; ++ks)
#pragma unroll
                  for (int vb = 0; vb < 2; ++vb) TR2(il[ks][vb], ih2[ks][vb], LA + HG_I + (32 * ks + trq) * HI_RS + vb * 32 + trp, LA + HG_I + (32 * ks + 4 + trq) * HI_RS + vb * 32 + trp);
#pragma unroll
              for (int ks = 0; ks < 4; ++ks) TR2(sl_[ks], sh_[ks], LA + HG_S + (32 * ks + trq) * HS_RS + vi * 32 + trp, LA + HG_S + (32 * ks + 4 + trq) * HS_RS + vi * 32 + trp);
#pragma unroll
              for (int ks = 0; ks < 2; ++ks) TR2(kl[ks], kh[ks], LA + HG_KE + (32 * ks + trq) * HE_RS + w * 32 + trp, LA + HG_KE + (32 * ks + 4 + trq) * HE_RS + w * 32 + trp);
              asm volatile("s_waitcnt lgkmcnt(0)" : "+v"(il[0][0]), "+v"(ih2[0][0]), "+v"(il[0][1]), "+v"(ih2[0][1]), "+v"(il[1][0]), "+v"(ih2[1][0]), "+v"(il[1][1]), "+v"(ih2[1][1]) :: "memory");
              asm volatile("" : "+v"(sl_[0]), "+v"(sh_[0]), "+v"(sl_[1]), "+v"(sh_[1]), "+v"(sl_[2]), "+v"(sh_[2]), "+v"(sl_[3]), "+v"(sh_[3]), "+v"(kl[0]), "+v"(kh[0]), "+v"(kl[1]), "+v"(kh[1]) :: "memory");
              __builtin_amdgcn_sched_barrier(0);
              f32x4 o = {0.f, 0.f, 0.f, 0.f};
#pragma unroll
              for (int ks = 0; ks < 2; ++ks) { const s16x8 ar = *(const LAS s16x8*)(L + HG_ATT + (16 * mi + fr) * HA_RS + 64 * ks + 16 * fq);
                  o = __builtin_amdgcn_mfma_f32_16x16x32_bf16(TRFRAG(s16x8, il[ks][vi], ih2[ks][vi]), ar, o, 0, 0, 0); }
#pragma unroll
              for (int ks = 0; ks < 4; ++ks) { const s16x8 qr = *(const LAS s16x8*)(L + HG_QD + (16 * mi + fr) * HQ_RS + 64 * ks + 16 * fq);
                  o = __builtin_amdgcn_mfma_f32_16x16x32_bf16(TRFRAG(s16x8, sl_[ks], sh_[ks]), qr, o, 0, 0, 0); }
              { u32x2 ow; ow.x = pkh(o[0], o[1]); ow.y = pkh(o[2], o[3]); *(u32x2*)(ib + ((size_t)c * 64 + 16 * mi + fr) * 512 + 16 * vi + 4 * fq) = ow; }
              const f32x4 dc = *(const LAS f32x4*)(L + HG_DEC + (16 * w + 4 * fq) * 4);
              S0 = S0 * dc; S1 = S1 * dc;
#pragma unroll
              for (int ks = 0; ks < 2; ++ks) { const s16x8 kf = TRFRAG(s16x8, kl[ks], kh[ks]);
                  S0 = __builtin_amdgcn_mfma_f32_16x16x32_bf16(kf, TRFRAG(s16x8, il[ks][0], ih2[ks][0]), S0, 0, 0, 0);
                  S1 = __builtin_amdgcn_mfma_f32_16x16x32_bf16(kf, TRFRAG(s16x8, il[ks][1], ih2[ks][1]), S1, 0, 0, 0); } }
            __syncthreads();
#pragma unroll
            for (int r = 0; r < 4; r += 2) { const unsigned a0 = cvt_pk_bf16(S0[r], S0[r + 1]), a1 = cvt_pk_bf16(S1[r], S1[r + 1]); const int kk = 16 * w + 4 * fq + r;
                *(LAS unsigned short*)(L + HG_S + kk * HS_RS + fr * 2) = (unsigned short)(a0 & 0xffffu); *(LAS unsigned short*)(L + HG_S + (kk + 1) * HS_RS + fr * 2) = (unsigned short)(a0 >> 16);
                *(LAS unsigned short*)(L + HG_S + kk * HS_RS + (16 + fr) * 2) = (unsigned short)(a1 & 0xffffu); *(LAS unsigned short*)(L + HG_S + (kk + 1) * HS_RS + (16 + fr) * 2) = (unsigned short)(a1 >> 16); }
        }
        __syncthreads();
    }
}

struct UnitUp { int pm, pn, half; };
struct PhUp {
    static constexpr int KT = 8, LDA = 1024, LDB = 1024; static constexpr bool PERM = true, GATHER = false;
    using Unit = UnitUp;
    g8::StaticOrder S; unsigned char* ws;
    __device__ __forceinline__ bool next(int i, Unit& u) const { g8::Tile t; if (!S.next(i >> 1, t)) return false; u.pm = t.pm; u.pn = t.pn; u.half = i & 1; return true; }
    __device__ __forceinline__ const char* a_ptr(const Unit& u) const { return (const char*)(ws + (u.half ? WS_QB : WS_UB)) + (size_t)u.pm * 256 * LDA; }
    __device__ __forceinline__ const char* b_ptr(const Unit& u) const { return (const char*)(ws + (u.half ? WS_WUB : WS_WUA)) + (size_t)u.pn * 256 * LDB; }
    __device__ __forceinline__ void a_off(const Unit&, const int (&)[2], const int (&)[2], unsigned (&)[2][2]) const {}
    __device__ __forceinline__ bool epi(f32x4 (&acc)[2][2][4][2], const Unit& u, int wr, int wc, int fr, int fq) const {
        const int row0 = u.pm * 256 + wr * 64 + fr, col0 = u.pn * 256 + wc * 32 + 8 * fq;
        h16* ga = (h16*)(ws + WS_GA); const h16* gb = (const h16*)(ws + WS_GB);
#pragma unroll
        for (int ai = 0; ai < 2; ++ai)
#pragma unroll
            for (int m = 0; m < 4; ++m) { const size_t off = (size_t)(row0 + ai * 128 + m * 16) * D + col0;
#pragma unroll
                for (int bj = 0; bj < 2; ++bj) { f32x4 b0, b1; unpk8(*(const u32x4*)(gb + off + bj * 128), b0, b1);
#pragma unroll
                    for (int j = 0; j < 4; ++j) { b0[j] = fmaxf(b0[j], 6.2e-5f); b1[j] = fmaxf(b1[j], 6.2e-5f); }
                    if (u.half == 0) { f32x4 a0, a1; unpk8(*(const u32x4*)(ga + off + bj * 128), a0, a1);
#pragma unroll
                        for (int j = 0; j < 4; ++j) { acc[ai][bj][m][0][j] *= a0[j] * __builtin_amdgcn_rcpf(b0[j]); acc[ai][bj][m][1][j] *= a1[j] * __builtin_amdgcn_rcpf(b1[j]); }
                    } else { *(u32x4*)(ga + off + bj * 128) = pk8(acc[ai][bj][m][0] * b0, acc[ai][bj][m][1] * b1); } }
                if (m & 1) asm volatile("" ::: "memory"); }
        return u.half == 0;
    }
};
struct PhOut {
    static constexpr int KT = 16, LDA = 2048, LDB = 2048; static constexpr bool PERM = false, GATHER = false;
    using Unit = g8::Tile;
    g8::StaticOrder S; unsigned char* ws; const float* x; float* out;
    __device__ __forceinline__ bool next(int i, Unit& u) const { return S.next(i, u); }
    __device__ __forceinline__ const char* a_ptr(const Unit& u) const { return (const char*)(ws + WS_GA) + (size_t)u.pm * 256 * LDA; }
    __device__ __forceinline__ const char* b_ptr(const Unit& u) const { return (const char*)(ws + WS_WOUT) + (size_t)u.pn * 256 * LDB; }
    __device__ __forceinline__ void a_off(const Unit&, const int (&)[2], const int (&)[2], unsigned (&)[2][2]) const {}
    __device__ __forceinline__ bool epi(const f32x4 (&acc)[2][2][4][2], const Unit& u, int wr, int wc, int fr, int fq) const {
        const int row0 = u.pm * 256 + wr * 64 + fr, col0 = u.pn * 256 + wc * 32 + 4 * fq;
#pragma unroll
        for (int ai = 0; ai < 2; ++ai)
#pragma unroll
            for (int m = 0; m < 4; ++m) { const size_t off = (size_t)(row0 + ai * 128 + m * 16) * D + col0;
#pragma unroll
                for (int bj = 0; bj < 2; ++bj)
#pragma unroll
                    for (int n = 0; n < 2; ++n) *(f32x4*)(out + off + bj * 128 + n * 16) = *(const f32x4*)(x + off + bj * 128 + n * 16) + acc[ai][bj][m][n];
                if (m & 1) asm volatile("" ::: "memory"); }
        return false;
    }
};
struct PhPle {
    static constexpr int KT = 4, LDA = 512, LDB = 512; static constexpr bool PERM = true, GATHER = false;
    using Unit = g8::Tile;
    g8::StaticOrder S; unsigned char* ws;
    __device__ __forceinline__ bool next(int i, Unit& u) const { return S.next(i, u); }
    __device__ __forceinline__ const char* a_ptr(const Unit& u) const { return (const char*)(ws + WS_P16) + (size_t)u.pm * 256 * LDA; }
    __device__ __forceinline__ const char* b_ptr(const Unit& u) const { return (const char*)(ws + WS_WPLE) + (size_t)u.pn * 256 * LDB; }
    __device__ __forceinline__ void a_off(const Unit&, const int (&)[2], const int (&)[2], unsigned (&)[2][2]) const {}
    __device__ __forceinline__ bool epi(const f32x4 (&acc)[2][2][4][2], const Unit& u, int wr, int wc, int fr, int fq) const {
        const int row0 = u.pm * 256 + wr * 64 + fr, col0 = u.pn * 256 + wc * 32 + 8 * fq; h16* pl = (h16*)(ws + WS_PL);
#pragma unroll
        for (int ai = 0; ai < 2; ++ai)
#pragma unroll
            for (int m = 0; m < 4; ++m) { const size_t off = (size_t)(row0 + ai * 128 + m * 16) * D + col0;
#pragma unroll
                for (int bj = 0; bj < 2; ++bj) *(u32x4*)(pl + off + bj * 128) = pk8(acc[ai][bj][m][0], acc[ai][bj][m][1]); }
        return false;
    }
};
struct PhPg {
    static constexpr int KT = 16, LDA = 2048, LDB = 2048; static constexpr bool PERM = true, GATHER = false;
    using Unit = g8::Tile;
    g8::StaticOrder S; unsigned char* ws; float* out;
    __device__ __forceinline__ bool next(int i, Unit& u) const { return S.next(i, u); }
    __device__ __forceinline__ const char* a_ptr(const Unit& u) const { return (const char*)(ws + WS_HB) + (size_t)u.pm * 256 * LDA; }
    __device__ __forceinline__ const char* b_ptr(const Unit& u) const { return (const char*)(ws + WS_WPG) + (size_t)u.pn * 256 * LDB; }
    __device__ __forceinline__ void a_off(const Unit&, const int (&)[2], const int (&)[2], unsigned (&)[2][2]) const {}
    __device__ __forceinline__ bool epi(const f32x4 (&acc)[2][2][4][2], const Unit& u, int wr, int wc, int fr, int fq) const {
        const int row0 = u.pm * 256 + wr * 64 + fr, col0 = u.pn * 256 + wc * 32 + 8 * fq; const h16* pl = (const h16*)(ws + WS_PL);
#pragma unroll
        for (int ai = 0; ai < 2; ++ai)
#pragma unroll
            for (int m = 0; m < 4; ++m) { const size_t off = (size_t)(row0 + ai * 128 + m * 16) * D + col0;
#pragma unroll
                for (int bj = 0; bj < 2; ++bj) { f32x4 p0, p1; unpk8(*(const u32x4*)(pl + off + bj * 128), p0, p1);
                    f32x4 x0 = *(const f32x4*)(out + off + bj * 128), x1 = *(const f32x4*)(out + off + bj * 128 + 4);
#pragma unroll
                    for (int j = 0; j < 4; ++j) { x0[j] += fsig(acc[ai][bj][m][0][j]) * p0[j]; x1[j] += fsig(acc[ai][bj][m][1][j]) * p1[j]; }
                    *(f32x4*)(out + off + bj * 128) = x0; *(f32x4*)(out + off + bj * 128 + 4) = x1; }
                asm volatile("" ::: "memory"); }
        return false;
    }
};

struct Args { P p; int ph_lo, ph_hi, use_bar, pad; };
__global__ void __launch_bounds__(512, 2) mega(Args a) {
    extern __shared__ __attribute__((aligned(16))) unsigned char lds_raw[];
    Frame F; F.lds = (LAS unsigned char*)lds_raw; F.tid = threadIdx.x; F.lane = F.tid & 63; F.wave = __builtin_amdgcn_readfirstlane(F.tid >> 6);
    F.G = gridDim.x; { const int bx = blockIdx.x; F.vcu = (F.G % 8 == 0) ? (bx % 8) * (F.G / 8) + bx / 8 : bx; }
    F.p = a.p;
    volatile LAS unsigned* MISC = (volatile LAS unsigned*)(F.lds + MISC_OFF);
    if (F.tid < 32) MISC[F.tid] = 0u;
    __syncthreads();
    XcdBarrier bar; bar.bar = (unsigned*)(a.p.ws + WS_CTL); bar.x = 0; bar.st = nullptr;
    if (a.use_bar) bar = xcd_barrier_post((unsigned*)(a.p.ws + WS_CTL), MISC + 8);
    const int lo = a.ph_lo, hi = a.ph_hi;
#define IN(k) (lo <= (k) && (k) < hi)
#define SEAM(k) do { if (IN(k) && IN((k) + 1)) xcd_barrier(bar); } while (0)
    unsigned char* ws = a.p.ws;
    if (IN(0)) { if (blockIdx.x == 0 && F.tid < 32) ((int*)(ws + WS_CNT))[F.tid] = 0; p0_prologue(F); } SEAM(0);
    if (IN(1)) {
#ifndef STAGGER1
#define STAGGER1 0
#endif
        if (STAGGER1 > 0 && ((blockIdx.x >> 3) & 1)) { const unsigned long long t0 = __builtin_amdgcn_s_memrealtime(); while (__builtin_amdgcn_s_memrealtime() - t0 < (unsigned long long)STAGGER1) __builtin_amdgcn_s_sleep(32); }
        PhIn ph; ph.S.init(T / 256, INC / 256, F.G, (int)blockIdx.x); ph.ws = ws; ph.noepi = a.pad; g8::gemm_phase(F.lds, ph); } SEAM(1);
    if (IN(2)) { hgrn_phase(F); } SEAM(2);
    if (IN(3)) { gmlp_phase(F); } SEAM(3);
    if (IN(4)) { PhUp ph; ph.S.init(T / 256, D / 256, F.G, (int)blockIdx.x); ph.ws = ws; g8::gemm_phase(F.lds, ph); } SEAM(4);
    if (IN(5)) { PhOut ph; ph.S.init(T / 256, D / 256, F.G, (int)blockIdx.x); ph.ws = ws; ph.x = a.p.x; ph.out = a.p.out; g8::gemm_phase(F.lds, ph); } SEAM(5);
    if (IN(6)) { route_phase(F); } SEAM(6);
    if (IN(7)) { PhMup ph; ph.S.init((const int*)(ws + WS_CNT), (int)blockIdx.x); ph.ws = ws; g8::gemm_phase(F.lds, ph); } SEAM(7);
    if (IN(8)) { PhMdn ph; ph.S.init((const int*)(ws + WS_CNT), (int)blockIdx.x); ph.ws = ws; g8::gemm_phase(F.lds, ph); } SEAM(8);
    if (IN(9)) { combine_phase(F); } SEAM(9);
    if (IN(10)) {
#ifndef SUB10
#define SUB10 3
#endif
        if (SUB10 & 1) { PhPle ph; ph.S.init(T / 256, D / 256, F.G, (int)blockIdx.x); ph.ws = ws; g8::gemm_phase(F.lds, ph); }
        if (SUB10 & 2) { PhPg ph; ph.S.init(T / 256, D / 256, F.G, (int)blockIdx.x); ph.ws = ws; ph.out = a.p.out; g8::gemm_phase(F.lds, ph); }
    } SEAM(10);
    if (IN(11)) { final_phase(F); }
#undef IN
#undef SEAM
}

__global__ void n_p16(P p) { size_t i = ((size_t)blockIdx.x * 256 + threadIdx.x) * 4; f32x4 v = *(const f32x4*)(p.p + i); u32x2 w; w.x = pkh(v.x, v.y); w.y = pkh(v.z, v.w); *(u32x2*)((h16*)(p.ws + WS_P16) + i) = w; }

static void launch_mega(const P& p, int lo, int hi, int use_bar, hipStream_t stream, int flags = 0) {
    Args a{}; a.p = p; a.ph_lo = lo; a.ph_hi = hi; a.use_bar = use_bar; a.pad = flags;
    hipLaunchKernelGGL(mega, dim3(256), dim3(512), LDS_BYTES, stream, a);
}

extern "C" void kernel_launch(void* const* d_in, const int* in_sizes, int n_in, void* d_out, int out_size, void* d_ws, size_t ws_size, hipStream_t stream) {
    static int ready = 0;
    if (!ready) {
        if (n_in != 23 || ws_size < WS_END) { fprintf(stderr, "kernel_launch: unexpected n_in %d / ws_size %zu\n", n_in, ws_size); ready = -1; return; }
        if (hipFuncSetAttribute((const void*)mega, hipFuncAttributeMaxDynamicSharedMemorySize, LDS_BYTES) != hipSuccess) { fprintf(stderr, "kernel_launch: hipFuncSetAttribute failed\n"); ready = -1; return; }
        ready = 1;
    }
    if (ready < 0) return;
    P p{};
    const float** f = (const float**)&p;
    for (int i = 0; i < 23; ++i) f[i] = (const float*)d_in[i];
    p.out = (float*)d_out; p.ws = (unsigned char*)d_ws;
    (void)hipMemsetAsync((char*)d_ws + WS_CNT, 0, 4096 + XCD_BAR_WORDS * 4, stream);
#ifdef OPTMASK
    launch_mega(p, 0, 1, 0, stream);
    if (OPTMASK & 2) launch_mega(p, 1, 2, 0, stream);
    else { n_rmsnorm<<<T / 4, 256, 0, stream>>>(p.x, p.g_mix, (h16*)(p.ws + WS_HB)); ngemm<0, F_in><<<dim3(INC / 64, T / 64), 256, 0, stream>>>(INC, D, F_in{p}); }
    if (OPTMASK & 4) launch_mega(p, 2, 3, 0, stream); else n_hgrn<<<64, 128, 0, stream>>>(p);
    if (OPTMASK & 8) launch_mega(p, 3, 4, 0, stream); else { n_lnv<<<T / 4, 256, 0, stream>>>(p); n_gmlp<<<dim3(T / 128, 8), 256, 0, stream>>>(p); n_hgfin<<<T / 4, 256, 0, stream>>>(p); }
    if (OPTMASK & 16) launch_mega(p, 4, 5, 0, stream); else ngemm<1, F_up><<<dim3(D / 64, T / 64), 256, 0, stream>>>(D, 512, F_up{p});
    if (OPTMASK & 32) launch_mega(p, 5, 6, 0, stream); else ngemm<0, F_out><<<dim3(D / 64, T / 64), 256, 0, stream>>>(D, D, F_out{p});
    if (OPTMASK & 64) launch_mega(p, 6, 7, 0, stream); else n_route<<<T / 4, 256, 0, stream>>>(p);
    if (OPTMASK & 128) launch_mega(p, 7, 8, 0, stream); else ngemm<1, F_mup><<<dim3(DE / 64, ECAP / 64, NE), 256, 0, stream>>>(DE, D, F_mup{p});
    if (OPTMASK & 256) launch_mega(p, 8, 9, 0, stream); else ngemm<0, F_mdn><<<dim3(D / 64, ECAP / 64, NE), 256, 0, stream>>>(D, DE, F_mdn{p});
    if (OPTMASK & 512) launch_mega(p, 9, 10, 0, stream); else n_combine<<<T / 4, 256, 0, stream>>>(p);
    if (OPTMASK & 1024) { if (!(OPTMASK & 64)) n_p16<<<T * PLE / 1024, 256, 0, stream>>>(p);
        if (!(SUB10 & 1)) ngemm<0, F_ple><<<dim3(D / 64, T / 64), 256, 0, stream>>>(D, PLE, F_ple{p});
        launch_mega(p, 10, 11, 0, stream);
        if (!(SUB10 & 2)) ngemm<0, F_pg><<<dim3(D / 64, T / 64), 256, 0, stream>>>(D, D, F_pg{p}); }
    else { ngemm<0, F_ple><<<dim3(D / 64, T / 64), 256, 0, stream>>>(D, PLE, F_ple{p}); ngemm<0, F_pg><<<dim3(D / 64, T / 64), 256, 0, stream>>>(D, D, F_pg{p}); }
    if (OPTMASK & 2048) launch_mega(p, 11, 12, 0, stream); else n_final<<<T / 4, 256, 0, stream>>>(p);
#else
#ifdef PROBE_REP
#ifndef PROBE_FLAGS
#define PROBE_FLAGS 0
#endif
    launch_mega(p, 0, PROBE_REP + 1, 1, stream, PROBE_FLAGS);
    (void)hipMemsetAsync((char*)d_ws + WS_CNT, 0, 4096 + XCD_BAR_WORDS * 4, stream);
#endif
    launch_mega(p, 0, 12, 1, stream);
#endif
}
```

```cpp
#include <hip/hip_runtime.h>
#include <cstdio>
#include <cstdint>

typedef _Float16 h16;
constexpr int T = 32768, D = 1024, SEQ = 2048, NB = 16, INC = 5120, PLE = 256;
constexpr int NE = 32, DE = 512, NA = 2 * T, ECAP = T;
constexpr float EPS = 1e-6f;

constexpr size_t MiB = 1024 * 1024;
constexpr size_t WS_HB = 0;
constexpr size_t WS_Z = 64 * MiB;
constexpr size_t WS_UB = WS_Z;
constexpr size_t WS_VB = WS_Z + 32 * MiB;
constexpr size_t WS_QB = WS_Z + 64 * MiB;
constexpr size_t WS_FB = WS_Z + 96 * MiB;
constexpr size_t WS_IB = WS_Z + 128 * MiB;
constexpr size_t WS_OB = WS_Z + 160 * MiB;
constexpr size_t WS_GA = WS_Z + 192 * MiB;
constexpr size_t WS_GB = WS_Z + 256 * MiB;
constexpr size_t WS_H = WS_Z;
constexpr size_t WS_Y = WS_Z + 64 * MiB;
constexpr size_t WS_PL = WS_Z + 192 * MiB;
constexpr size_t WS_W = 384 * MiB;
constexpr size_t WS_MISC = 498 * MiB;
constexpr size_t WS_LIST = WS_MISC;
constexpr size_t WS_GATE = WS_MISC + 4 * MiB;
constexpr size_t WS_CNT = WS_MISC + 5 * MiB;
constexpr size_t WS_END = WS_MISC + 6 * MiB;

struct P {
    const float *x, *p, *g_mix, *w_in, *gm_ln_g, *gm_ln_b, *gm_w_sp, *gm_b_sp, *w_up_a, *hg_lb, *hg_norm_g, *w_up_b, *w_out, *g_ffn,
        *w_grp, *w_exp, *w1, *w3, *w2, *g_ple, *w_pg, *w_ple, *g_final;
    float* out; unsigned char* ws;
};

__device__ __forceinline__ float sigm(float v) { return 1.f / (1.f + expf(-v)); }
__device__ __forceinline__ float gelu_t(float v) { return v * sigm(1.5957691216057308f * (v + 0.044715f * v * v * v)); }
__device__ __forceinline__ float wave_sum(float v) {
#pragma unroll
    for (int o = 1; o < 64; o <<= 1) v += __shfl_xor(v, o);
    return v;
}

__global__ void n_rmsnorm(const float* x, const float* g, h16* out) {
    int row = blockIdx.x * 4 + (threadIdx.x >> 6), lane = threadIdx.x & 63;
    const float* xr = x + (size_t)row * D; float v[16]; float s = 0.f;
    for (int j = 0; j < 16; ++j) { v[j] = xr[lane + 64 * j]; s += v[j] * v[j]; }
    float r = rsqrtf(wave_sum(s) * (1.f / D) + EPS);
    for (int j = 0; j < 16; ++j) out[(size_t)row * D + lane + 64 * j] = (h16)(v[j] * r * g[lane + 64 * j]);
}

template <int DUAL, class F>
__global__ void __launch_bounds__(256) ngemm(int N, int K, F f) {
    __shared__ float As[DUAL + 1][16][65], Bs[DUAL + 1][16][65];
    const int M = f.rows(); const int r0 = blockIdx.y * 64, c0 = blockIdx.x * 64;
    if (r0 >= M) return;
    const int tx = threadIdx.x & 15, ty = threadIdx.x >> 4;
    float acc[DUAL + 1][4][4] = {};
    for (int k0 = 0; k0 < K; k0 += 16) {
        for (int w = 0; w <= DUAL; ++w)
            for (int i = threadIdx.x; i < 1024; i += 256) {
                int r = i >> 4, kk = i & 15; As[w][kk][r] = (r0 + r < M) ? f.fa(r0 + r, k0 + kk, w) : 0.f;
                int kb = i >> 6, c = i & 63; Bs[w][kb][c] = f.fb(k0 + kb, c0 + c, w);
            }
        __syncthreads();
        for (int w = 0; w <= DUAL; ++w)
#pragma unroll
            for (int kk = 0; kk < 16; ++kk) {
                float a[4], b[4];
#pragma unroll
                for (int i = 0; i < 4; ++i) { a[i] = As[w][kk][ty * 4 + i]; b[i] = Bs[w][kk][tx * 4 + i]; }
#pragma unroll
                for (int i = 0; i < 4; ++i)
#pragma unroll
                    for (int j = 0; j < 4; ++j) acc[w][i][j] += a[i] * b[j];
            }
        __syncthreads();
    }
    for (int i = 0; i < 4; ++i) for (int j = 0; j < 4; ++j) { int r = r0 + ty * 4 + i, c = c0 + tx * 4 + j; if (r < M) f.fe(r, c, acc[0][i][j], acc[DUAL][i][j]); }
}

struct F_in {
    P p;
    __device__ int rows() const { return T; }
    __device__ float fa(int r, int k, int) const { return (float)((const h16*)(p.ws + WS_HB))[(size_t)r * D + k]; }
    __device__ float fb(int k, int c, int) const { return p.w_in[(size_t)k * INC + c]; }
    __device__ void fe(int r, int c, float a, float) const {
        unsigned char* ws = p.ws; int part = c >> 9;
        if (part == 0) ((h16*)(ws + WS_UB))[(size_t)r * 512 + c] = (h16)gelu_t(a);
        else if (part == 1) ((h16*)(ws + WS_VB))[(size_t)r * 512 + c - 512] = (h16)gelu_t(a);
        else if (part == 2) ((h16*)(ws + WS_QB))[(size_t)r * 512 + c - 1024] = (h16)(a * sigm(a));
        else if (part == 3) { int j = c - 1536; float lb = 1.f / (1.f + expf(p.hg_lb[512 + j] - p.hg_lb[j])); float fv = lb + (1.f - lb) * sigm(a);
            ((h16*)(ws + WS_FB))[(size_t)r * 512 + j] = (h16)logf(fv); }
        else if (part == 4) ((h16*)(ws + WS_IB))[(size_t)r * 512 + c - 2048] = (h16)a;
        else if (part == 5) ((h16*)(ws + WS_OB))[(size_t)r * 512 + c - 2560] = (h16)a;
        else if (part < 8) ((h16*)(ws + WS_GA))[(size_t)r * D + c - 3072] = (h16)sigm(a);
        else ((h16*)(ws + WS_GB))[(size_t)r * D + c - 4096] = (h16)sigm(a);
    }
};

__global__ void n_lnv(P p) {
    int row = blockIdx.x * 4 + (threadIdx.x >> 6), lane = threadIdx.x & 63;
    h16* vr = (h16*)(p.ws + WS_VB) + (size_t)row * 512; float v[8]; float s = 0.f;
    for (int j = 0; j < 8; ++j) { v[j] = (float)vr[lane + 64 * j]; s += v[j]; }
    float mu = wave_sum(s) * (1.f / 512); float q = 0.f;
    for (int j = 0; j < 8; ++j) { v[j] -= mu; q += v[j] * v[j]; }
    float r = rsqrtf(wave_sum(q) * (1.f / 512) + EPS);
    for (int j = 0; j < 8; ++j) { int c = lane + 64 * j; vr[c] = (h16)(v[j] * r * p.gm_ln_g[c] + p.gm_ln_b[c]); }
}
__global__ void __launch_bounds__(256) n_gmlp(P p) {
    __shared__ float vs[128][65];
    const int tile = blockIdx.x, g = blockIdx.y; const size_t t0 = (size_t)tile * 128;
    const h16* vb = (const h16*)(p.ws + WS_VB); h16* ub = (h16*)(p.ws + WS_UB);
    for (int i = threadIdx.x; i < 128 * 64; i += 256) { int s = i >> 6, d = i & 63; vs[s][d] = (float)vb[(t0 + s) * 512 + g * 64 + d]; }
    __syncthreads();
    for (int i = threadIdx.x; i < 128 * 64; i += 256) { int t = i >> 6, d = i & 63; float acc = 0.f;
        const float* w = p.gm_w_sp + ((size_t)g * 128 + t) * 128;
        for (int s = 0; s <= t; ++s) acc += w[s] * vs[s][d];
        acc += p.gm_b_sp[g * 128 + t];
        size_t o = (t0 + t) * 512 + g * 64 + d; ub[o] = (h16)((float)ub[o] * acc); }
}
__global__ void __launch_bounds__(128) n_hgrn(P p) {
    __shared__ float fk[128], kk[128], qk[128];
    const int b = blockIdx.x >> 2, h = blockIdx.x & 3, v = threadIdx.x;
    const h16* qb = (const h16*)(p.ws + WS_QB); const h16* fb = (const h16*)(p.ws + WS_FB); h16* ib = (h16*)(p.ws + WS_IB);
    float S[128];
#pragma unroll
    for (int k = 0; k < 128; ++k) S[k] = 0.f;
    for (int t = 0; t < SEQ; ++t) {
        size_t o = ((size_t)b * SEQ + t) * 512 + h * 128 + v;
        float f = expf((float)fb[o]); fk[v] = f; kk[v] = 1.f - f; qk[v] = (float)qb[o]; float iv = (float)ib[o];
        __syncthreads();
        float acc = 0.f;
#pragma unroll
        for (int k = 0; k < 128; ++k) { S[k] = fk[k] * S[k] + kk[k] * iv; acc += S[k] * qk[k]; }
        __syncthreads();
        ib[o] = (h16)acc;
    }
}
__global__ void n_hgfin(P p) {
    int row = blockIdx.x * 4 + (threadIdx.x >> 6), lane = threadIdx.x & 63;
    const h16* ob = (const h16*)(p.ws + WS_IB) + (size_t)row * 512; const h16* og = (const h16*)(p.ws + WS_OB) + (size_t)row * 512; h16* yb = (h16*)(p.ws + WS_QB) + (size_t)row * 512;
    int c0 = (lane >> 4) * 128 + (lane & 15) * 8; float v[8]; float s = 0.f;
    for (int j = 0; j < 8; ++j) { v[j] = (float)ob[c0 + j]; s += v[j] * v[j]; }
    for (int o = 1; o < 16; o <<= 1) s += __shfl_xor(s, o);
    float r = rsqrtf(s * (1.f / 128) + EPS);
    for (int j = 0; j < 8; ++j) yb[c0 + j] = (h16)(v[j] * r * p.hg_norm_g[c0 + j] * sigm((float)og[c0 + j]));
}
struct F_up {
    P p;
    __device__ int rows() const { return T; }
    __device__ float fa(int r, int k, int w) const { return (float)((const h16*)(p.ws + (w ? WS_QB : WS_UB)))[(size_t)r * 512 + k]; }
    __device__ float fb(int k, int c, int w) const { return (w ? p.w_up_b : p.w_up_a)[(size_t)k * D + c]; }
    __device__ void fe(int r, int c, float a0, float a1) const { h16* ga = (h16*)(p.ws + WS_GA); const h16* gb = (const h16*)(p.ws + WS_GB); size_t o = (size_t)r * D + c;
        ga[o] = (h16)((float)ga[o] * a0 + (float)gb[o] * a1); }
};
struct F_out {
    P p;
    __device__ int rows() const { return T; }
    __device__ float fa(int r, int k, int) const { return (float)((const h16*)(p.ws + WS_GA))[(size_t)r * D + k]; }
    __device__ float fb(int k, int c, int) const { return p.w_out[(size_t)k * D + c]; }
    __device__ void fe(int r, int c, float a, float) const { size_t o = (size_t)r * D + c; p.out[o] = p.x[o] + a; }
};
__global__ void n_route(P p) {
    int row = blockIdx.x * 4 + (threadIdx.x >> 6), lane = threadIdx.x & 63;
    const float* xr = p.out + (size_t)row * D; float v[16]; float s = 0.f;
    for (int j = 0; j < 16; ++j) { v[j] = xr[lane + 64 * j]; s += v[j] * v[j]; }
    float r = rsqrtf(wave_sum(s) * (1.f / D) + EPS);
    h16* hb = (h16*)(p.ws + WS_HB) + (size_t)row * D;
    for (int j = 0; j < 16; ++j) { v[j] = v[j] * r * p.g_ffn[lane + 64 * j]; hb[lane + 64 * j] = (h16)v[j]; }
    __shared__ float lgs[4][40]; float* lg = lgs[threadIdx.x >> 6]; float* le = lg + 4;
    for (int n = 0; n < 4; ++n) { float a = 0.f; for (int j = 0; j < 16; ++j) a += v[j] * p.w_grp[(size_t)(lane + 64 * j) * 4 + n]; a = wave_sum(a); if (lane == 0) lg[n] = a; }
    for (int n = 0; n < 32; ++n) { float a = 0.f; for (int j = 0; j < 16; ++j) a += v[j] * p.w_exp[(size_t)(lane + 64 * j) * 32 + n]; a = wave_sum(a); if (lane == 0) le[n] = a; }
    if (lane == 0) {
        int gs = 0; for (int n = 1; n < 4; ++n) if (lg[n] > lg[gs]) gs = n;
        float den = 0.f; for (int n = 0; n < 4; ++n) den += expf(lg[n] - lg[gs]); float pg = 1.f / den;
        int e0 = 0; for (int n = 1; n < 8; ++n) if (le[gs * 8 + n] > le[gs * 8 + e0]) e0 = n;
        int e1 = (e0 == 0) ? 1 : 0; for (int n = 0; n < 8; ++n) if (n != e0 && le[gs * 8 + n] > le[gs * 8 + e1]) e1 = n;
        float l0 = le[gs * 8 + e0], l1 = le[gs * 8 + e1]; float w1 = expf(l1 - l0); float g0 = pg / (1.f + w1), g1 = pg * w1 / (1.f + w1);
        int* cnt = (int*)(p.ws + WS_CNT); int* list = (int*)(p.ws + WS_LIST); float* gate = (float*)(p.ws + WS_GATE);
        int E0 = gs * 8 + e0, E1 = gs * 8 + e1;
        int p0 = atomicAdd(&cnt[E0], 1); list[(size_t)E0 * ECAP + p0] = 2 * row; gate[2 * row] = g0;
        int p1 = atomicAdd(&cnt[E1], 1); list[(size_t)E1 * ECAP + p1] = 2 * row + 1; gate[2 * row + 1] = g1;
    }
}
struct F_mup {
    P p;
    __device__ int rows() const { return ((const int*)(p.ws + WS_CNT))[blockIdx.z]; }
    __device__ float fa(int r, int k, int) const { int a = ((const int*)(p.ws + WS_LIST))[(size_t)blockIdx.z * ECAP + r]; return (float)((const h16*)(p.ws + WS_HB))[(size_t)(a >> 1) * D + k]; }
    __device__ float fb(int k, int c, int w) const { return (w ? p.w3 : p.w1)[((size_t)blockIdx.z * D + k) * DE + c]; }
    __device__ void fe(int r, int c, float a0, float a1) const { int a = ((const int*)(p.ws + WS_LIST))[(size_t)blockIdx.z * ECAP + r];
        ((h16*)(p.ws + WS_H))[(size_t)a * DE + c] = (h16)(a0 * sigm(a0) * a1); }
};
struct F_mdn {
    P p;
    __device__ int rows() const { return ((const int*)(p.ws + WS_CNT))[blockIdx.z]; }
    __device__ float fa(int r, int k, int) const { int a = ((const int*)(p.ws + WS_LIST))[(size_t)blockIdx.z * ECAP + r]; return (float)((const h16*)(p.ws + WS_H))[(size_t)a * DE + k]; }
    __device__ float fb(int k, int c, int) const { return p.w2[((size_t)blockIdx.z * DE + k) * D + c]; }
    __device__ void fe(int r, int c, float a0, float) const { int a = ((const int*)(p.ws + WS_LIST))[(size_t)blockIdx.z * ECAP + r];
        ((h16*)(p.ws + WS_Y))[(size_t)a * D + c] = (h16)(a0 * ((const float*)(p.ws + WS_GATE))[a]); }
};
__global__ void n_combine(P p) {
    int row = blockIdx.x * 4 + (threadIdx.x >> 6), lane = threadIdx.x & 63;
    float* xr = p.out + (size_t)row * D; const h16* y0 = (const h16*)(p.ws + WS_Y) + (size_t)(2 * row) * D; float v[16]; float s = 0.f;
    for (int j = 0; j < 16; ++j) { int c = lane + 64 * j; v[j] = xr[c] + (float)y0[c] + (float)y0[D + c]; xr[c] = v[j]; s += v[j] * v[j]; }
    float r = rsqrtf(wave_sum(s) * (1.f / D) + EPS);
    h16* hb = (h16*)(p.ws + WS_HB) + (size_t)row * D;
    for (int j = 0; j < 16; ++j) hb[lane + 64 * j] = (h16)(v[j] * r * p.g_ple[lane + 64 * j]);
}
struct F_ple {
    P p;
    __device__ int rows() const { return T; }
    __device__ float fa(int r, int k, int) const { return p.p[(size_t)r * PLE + k]; }
    __device__ float fb(int k, int c, int) const { return p.w_ple[(size_t)k * D + c]; }
    __device__ void fe(int r, int c, float a, float) const { ((h16*)(p.ws + WS_PL))[(size_t)r * D + c] = (h16)a; }
};
struct F_pg {
    P p;
    __device__ int rows() const { return T; }
    __device__ float fa(int r, int k, int) const { return (float)((const h16*)(p.ws + WS_HB))[(size_t)r * D + k]; }
    __device__ float fb(int k, int c, int) const { return p.w_pg[(size_t)k * D + c]; }
    __device__ void fe(int r, int c, float a, float) const { size_t o = (size_t)r * D + c; p.out[o] = p.out[o] + sigm(a) * (float)((const h16*)(p.ws + WS_PL))[o]; }
};
__global__ void n_final(P p) {
    int row = blockIdx.x * 4 + (threadIdx.x >> 6), lane = threadIdx.x & 63;
    float* xr = p.out + (size_t)row * D; float v[16]; float s = 0.f;
    for (int j = 0; j < 16; ++j) { v[j] = xr[lane + 64 * j]; s += v[j] * v[j]; }
    float r = rsqrtf(wave_sum(s) * (1.f / D) + EPS);
    for (int j = 0; j < 16; ++j) xr[lane + 64 * j] = v[j] * r * p.g_final[lane + 64 * j];
}


#define LAS __attribute__((address_space(3)))
typedef _Float16 h16x8 __attribute__((ext_vector_type(8)));
typedef _Float16 h16x4 __attribute__((ext_vector_type(4)));
typedef _Float16 h16x2 __attribute__((ext_vector_type(2)));
typedef float f32x4 __attribute__((ext_vector_type(4)));
typedef float f32x2 __attribute__((ext_vector_type(2)));
typedef unsigned u32x4 __attribute__((ext_vector_type(4)));
typedef unsigned u32x2 __attribute__((ext_vector_type(2)));

constexpr size_t WS_WIN = WS_W;
constexpr size_t WS_W13 = WS_W + 10 * MiB;
constexpr size_t WS_W2 = WS_W + 74 * MiB;
constexpr size_t WS_WPG = WS_W + 106 * MiB;
constexpr size_t WS_WOUT = WS_W + 108 * MiB;
constexpr size_t WS_WUA = WS_W + 110 * MiB;
constexpr size_t WS_WUB = WS_W + 111 * MiB;
constexpr size_t WS_WPLE = WS_W + 112 * MiB;
constexpr size_t WS_WSP = WS_W + 112 * MiB + 512 * 1024;
constexpr size_t WS_WR = WS_W + 112 * MiB + 768 * 1024;
constexpr size_t WS_LB = WS_W + 112 * MiB + 896 * 1024;
constexpr size_t WS_P16 = WS_Z + 256 * MiB;
constexpr size_t WS_RSTD = WS_MISC + 4 * MiB + 512 * 1024;
constexpr size_t WS_CTL = WS_MISC + 5 * MiB + 4096;
static_assert(WS_LB + 2048 <= WS_MISC, "weight map");

__device__ __forceinline__ float fsig(float v) { return __builtin_amdgcn_rcpf(1.f + __builtin_amdgcn_exp2f(-1.4426950408889634f * v)); }
__device__ __forceinline__ float fgelu(float v) { return v * fsig(1.5957691216057308f * (v + 0.044715f * v * v * v)); }
__device__ __forceinline__ unsigned pkh(float a, float b) { h16x2 t; t.x = (h16)a; t.y = (h16)b; return __builtin_bit_cast(unsigned, t); }
__device__ __forceinline__ u32x4 pk8(f32x4 a, f32x4 b) { u32x4 w; w.x = pkh(a[0], a[1]); w.y = pkh(a[2], a[3]); w.z = pkh(b[0], b[1]); w.w = pkh(b[2], b[3]); return w; }
__device__ __forceinline__ void unpk8(u32x4 w, f32x4& a, f32x4& b) {
    const h16x8 t = __builtin_bit_cast(h16x8, w);
    a = (f32x4){(float)t[0], (float)t[1], (float)t[2], (float)t[3]}; b = (f32x4){(float)t[4], (float)t[5], (float)t[6], (float)t[7]}; }

namespace g8 {
constexpr int BM = 256, BK = 64, HALF = 128, HTB = HALF * BK * 2, STAGE_BYTES = 8 * HTB, NXCD = 8, WGM = 8;
__device__ __forceinline__ int lds_byte(int r, int c) { const int st = (r >> 4) * 2 + (c >> 5), rr = r & 15, cc = c & 31, ob = rr * 64 + cc * 2; return st * 1024 + (ob ^ (((ob >> 9) & 1) << 5)); }
__device__ __forceinline__ void stage_rc(int b, int& R, int& C) { const int st = b / 1024, sb = b % 1024, swz = sb ^ (((sb >> 9) & 1) << 5); R = (st >> 1) * 16 + swz / 64; C = (st & 1) * 32 + (swz % 64) / 2; }
__device__ __forceinline__ int perm32(int rho) { const int n = rho >> 4, i = rho & 15; return 8 * (i >> 2) + 4 * n + (i & 3); }
struct Tile { int pm, pn; };
struct StaticOrder {
    int nM, nN, nwg, G, c;
    __device__ void init(int nM_, int nN_, int G_, int c_) { nM = nM_; nN = nN_; nwg = nM * nN; G = G_; c = c_; }
    __device__ bool next(int i, Tile& u) const {
        const long L = (long)i * G + c; if (L >= nwg) return false;
        int wgid = (int)L; { const int q = nwg / NXCD, r = nwg % NXCD, xcd = wgid % NXCD, off = wgid / NXCD; wgid = (xcd < r ? xcd * (q + 1) : r * (q + 1) + (xcd - r) * q) + off; }
        const int nig = WGM * nN, gid = wgid / nig, fm = gid * WGM, gsz = (nM - fm) < WGM ? (nM - fm) : WGM;
        u.pm = fm + ((wgid % nig) % gsz); u.pn = (wgid % nig) / gsz; return true;
    }
};
template <class PH>
__device__ __forceinline__ void gemm_phase(LAS unsigned char* lds, const PH& ph) {
    const int tid = threadIdx.x, wid = __builtin_amdgcn_readfirstlane(tid >> 6), lane = tid & 63, wr = wid >> 2, wc = wid & 3, fr = lane & 15, fq = lane >> 4;
    constexpr int nt = PH::KT;
    int R[2], C[2]; unsigned voffB[2], voffA[2];
#pragma unroll
    for (int i = 0; i < 2; ++i) { stage_rc(tid * 16 + i * 8192, R[i], C[i]); const int Rb = PH::PERM ? ((R[i] & ~31) + perm32(R[i] & 31)) : R[i]; voffB[i] = (unsigned)(Rb * PH::LDB + C[i] * 2); voffA[i] = (unsigned)(R[i] * PH::LDA + C[i] * 2); }
    constexpr size_t kstep = BK * 2, hstepB = (size_t)HALF * PH::LDB, hstepA = PH::GATHER ? 0 : (size_t)HALF * PH::LDA;
    const unsigned ldsw = (unsigned)wid * 1024u;
    const int aoff = lds_byte(wr * 64 + fr, fq * 8), boff = lds_byte(wc * 32 + fr, fq * 8);
#define G8_SA(b, h) (((b) * 2 + (h)) * HTB)
#define G8_SB(b, h) ((4 + (b) * 2 + (h)) * HTB)
#define G8_STG(bufoff, gptr, o0, o1) do { \
        __builtin_amdgcn_global_load_lds((const unsigned*)((gptr) + (o0)), (LAS unsigned*)(lds + (bufoff) + ldsw), 16, 0, 0); \
        __builtin_amdgcn_global_load_lds((const unsigned*)((gptr) + (o1)), (LAS unsigned*)(lds + (bufoff) + ldsw + 8192), 16, 0, 0); } while (0)
#define G8_STGB(bufoff, gptr) G8_STG(bufoff, gptr, voffB[0], voffB[1])
#define G8_STGA(bufoff, gptr, h, useN) do { if constexpr (PH::GATHER) { G8_STG(bufoff, gptr, ((useN) ? na[h][0] : ca[h][0]), ((useN) ? na[h][1] : ca[h][1])); } \
        else { G8_STG(bufoff, (gptr) + (h) * hstepA, voffA[0], voffA[1]); } } while (0)
#define G8_LDA(dst, b, h) do { _Pragma("unroll") for (int m = 0; m < 4; ++m) _Pragma("unroll") for (int k = 0; k < 2; ++k) dst[m][k] = *(const LAS h16x8*)(lds + G8_SA(b, h) + aoff + m * 2048 + k * 1024); } while (0)
#define G8_LDB(dst, b, h) do { _Pragma("unroll") for (int n = 0; n < 2; ++n) _Pragma("unroll") for (int k = 0; k < 2; ++k) dst[n][k] = *(const LAS h16x8*)(lds + G8_SB(b, h) + boff + n * 2048 + k * 1024); } while (0)
#define G8_MMA(ai, bj, At, Bt) do { __builtin_amdgcn_s_setprio(1); _Pragma("unroll") for (int m = 0; m < 4; ++m) _Pragma("unroll") for (int n = 0; n < 2; ++n) _Pragma("unroll") for (int k = 0; k < 2; ++k) \
        acc[ai][bj][m][n] = __builtin_amdgcn_mfma_f32_16x16x32_f16(Bt[n][k], At[m][k], acc[ai][bj][m][n], 0, 0, 0); __builtin_amdgcn_s_setprio(0); } while (0)
#define G8_WAIT_V(n) asm volatile("s_waitcnt vmcnt(" #n ")" ::: "memory")
#define G8_WAIT_L(n) asm volatile("s_waitcnt lgkmcnt(" #n ")" ::: "memory")
#define G8_BAR __builtin_amdgcn_s_barrier()
#define G8_SCHED __builtin_amdgcn_sched_barrier(0)
    typename PH::Unit cur, nxt; int ui = 0;
    if (!ph.next(0, cur)) return;
    f32x4 acc[2][2][4][2];
#pragma unroll
    for (int a = 0; a < 2; ++a)
#pragma unroll
        for (int b = 0; b < 2; ++b)
#pragma unroll
            for (int m = 0; m < 4; ++m)
#pragma unroll
                for (int n = 0; n < 2; ++n) acc[a][b][m][n] = (f32x4){0.f, 0.f, 0.f, 0.f};
    h16x8 At[4][2], B0[2][2], B1[2][2];
    unsigned ca[2][2], na[2][2];
    if constexpr (PH::GATHER) ph.a_off(cur, R, C, ca);
    const char* cA = ph.a_ptr(cur); const char* cB = ph.b_ptr(cur);
    G8_STGB(G8_SB(0, 0), cB); G8_STGB(G8_SB(0, 1), cB + hstepB); G8_STGA(G8_SA(0, 0), cA, 0, false); G8_STGA(G8_SA(0, 1), cA, 1, false);
    if (wr == 1) G8_BAR;
    G8_WAIT_V(2); G8_BAR;
    G8_STGB(G8_SB(1, 0), cB + kstep); G8_STGA(G8_SA(1, 0), cA + kstep, 0, false); G8_STGB(G8_SB(1, 1), cB + hstepB + kstep);
    G8_WAIT_V(6); G8_BAR;
    for (;;) {
        const bool has_next = ph.next(ui + 1, nxt);
        const char* nA; const char* nB;
        if (has_next) { if constexpr (PH::GATHER) ph.a_off(nxt, R, C, na); nA = ph.a_ptr(nxt); nB = ph.b_ptr(nxt); }
        else { if constexpr (PH::GATHER) { na[0][0] = ca[0][0]; na[0][1] = ca[0][1]; na[1][0] = ca[1][0]; na[1][1] = ca[1][1]; } nA = cA; nB = cB; }
#pragma unroll 1
        for (int t = 0; t < nt; t += 2) {
            const bool last = (t == nt - 2);
            const char* a1 = cA + (size_t)(t + 1) * kstep;
            const char* a2 = last ? nA : cA + (size_t)(t + 2) * kstep; const char* b2 = last ? nB : cB + (size_t)(t + 2) * kstep;
            const char* a3 = a2 + kstep; const char* b3 = b2 + kstep;
            G8_LDB(B0, 0, 0); G8_LDB(B1, 0, 1); G8_SCHED; G8_LDA(At, 0, 0); G8_STGA(G8_SA(1, 1), a1, 1, false);
            G8_WAIT_V(8); G8_WAIT_L(0); G8_BAR; G8_MMA(0, 0, At, B0); G8_MMA(0, 1, At, B1); G8_BAR; G8_SCHED;
            G8_LDA(At, 0, 1); G8_STGB(G8_SB(0, 0), b2); G8_STGB(G8_SB(0, 1), b2 + hstepB); G8_STGA(G8_SA(0, 0), a2, 0, last);
            G8_WAIT_V(8); G8_WAIT_L(0); G8_BAR; G8_MMA(1, 0, At, B0); G8_MMA(1, 1, At, B1); G8_BAR; G8_SCHED;
            G8_LDB(B0, 1, 0); G8_LDB(B1, 1, 1); G8_SCHED; G8_LDA(At, 1, 0); G8_STGA(G8_SA(0, 1), a2, 1, last);
            G8_WAIT_V(8); G8_WAIT_L(0); G8_BAR; G8_MMA(0, 0, At, B0); G8_MMA(0, 1, At, B1); G8_BAR; G8_SCHED;
            G8_LDA(At, 1, 1); G8_STGB(G8_SB(1, 0), b3); G8_STGB(G8_SB(1, 1), b3 + hstepB); G8_STGA(G8_SA(1, 0), a3, 0, last);
            G8_WAIT_V(8); G8_WAIT_L(0); G8_BAR; G8_MMA(1, 0, At, B0); G8_MMA(1, 1, At, B1); G8_BAR; G8_SCHED;
        }
        if (wr == 0) G8_BAR;
        const bool keep = ph.epi(acc, cur, wr, wc, fr, fq);
        if (!has_next) break;
        if (!keep) {
#pragma unroll
            for (int a = 0; a < 2; ++a)
#pragma unroll
                for (int b = 0; b < 2; ++b)
#pragma unroll
                    for (int m = 0; m < 4; ++m)
#pragma unroll
                        for (int n = 0; n < 2; ++n) acc[a][b][m][n] = (f32x4){0.f, 0.f, 0.f, 0.f};
        }
        cur = nxt; cA = nA; cB = nB; if constexpr (PH::GATHER) { ca[0][0] = na[0][0]; ca[0][1] = na[0][1]; ca[1][0] = na[1][0]; ca[1][1] = na[1][1]; } ++ui;
        if (wr == 1) G8_BAR;
    }
    G8_WAIT_V(0);
    G8_BAR;
#undef G8_SA
#undef G8_SB
#undef G8_STG
#undef G8_STGB
#undef G8_STGA
#undef G8_LDA
#undef G8_LDB
#undef G8_MMA
#undef G8_WAIT_V
#undef G8_WAIT_L
#undef G8_BAR
#undef G8_SCHED
}
}

#define XB_TMO      128
#define XB_XCNT(j)  (256  + 64 * (j))
#define XB_XSUB(j)  (1280 + 64 * (j))
#define XB_XGEN(j)  (2304 + 64 * (j))
#define XB_TOP      3328
#define XB_TOPGEN   3392
#define XCD_BAR_WORDS 3456
#define XB_SPIN_CAP (1u << 18)
__device__ __forceinline__ unsigned xb_ld(unsigned* p)              { return __hip_atomic_load(p, __ATOMIC_RELAXED, __HIP_MEMORY_SCOPE_AGENT); }
__device__ __forceinline__ unsigned xb_add(unsigned* p, unsigned v) { return __hip_atomic_fetch_add(p, v, __ATOMIC_RELAXED, __HIP_MEMORY_SCOPE_AGENT); }
__device__ __forceinline__ unsigned xb_xcc_id() { return (unsigned)__builtin_amdgcn_s_getreg((3 << 11) | 20) & 0xFu; }
#define XB_SPIN(cond, bar) do { unsigned _sp = 0; while (cond) { __builtin_amdgcn_s_sleep(1); \
    if ((++_sp & 255u) == 0u) { if (xb_ld(&(bar)[XB_TMO])) break; if (_sp > XB_SPIN_CAP) { atomicAdd(&(bar)[XB_TMO], 1u); break; } } } } while (0)
struct XcdBarrier { unsigned* bar; unsigned x; volatile LAS unsigned* st; };
__device__ __forceinline__ XcdBarrier xcd_barrier_post(unsigned* bar, volatile LAS unsigned* st) {
    XcdBarrier b; b.bar = bar; b.x = xb_xcc_id(); b.st = st;
    if (threadIdx.x == 0) (void)xb_add(&bar[XB_XCNT(b.x)], 1u);
    return b;
}
__device__ __forceinline__ void xcd_barrier_complete(unsigned* bar, unsigned x, unsigned& nloc, unsigned& nx) {
    const unsigned G = gridDim.x * gridDim.y * gridDim.z;
    unsigned sum, cnt, mine, sp = 0u;
    for (;;) {
        sum = 0u; cnt = 0u; mine = 0u;
#pragma unroll
        for (unsigned j = 0; j < 16; ++j) { const unsigned c = xb_ld(&bar[XB_XCNT(j)]); sum += c; cnt += (c > 0u) ? 1u : 0u; mine = (j == x) ? c : mine; }
        if (sum == G) break;
        __builtin_amdgcn_s_sleep(1);
        if ((++sp & 255u) == 0u) { if (xb_ld(&bar[XB_TMO])) break; if (sp > XB_SPIN_CAP) { atomicAdd(&bar[XB_TMO], 1u); break; } }
    }
    nloc = mine > 0u ? mine : 1u; nx = cnt > 0u ? cnt : 1u;
}
__device__ __forceinline__ void xcd_barrier(const XcdBarrier& b) {
    asm volatile("s_waitcnt vmcnt(0)" ::: "memory");
    __syncthreads();
    if (threadIdx.x == 0) {
        unsigned* bar = b.bar;
        __builtin_amdgcn_s_waitcnt(0);
        unsigned nloc = b.st[0], nx = b.st[1];
        if (nloc == 0u) { xcd_barrier_complete(bar, b.x, nloc, nx); b.st[0] = nloc; b.st[1] = nx; }
        const unsigned old = xb_add(&bar[XB_XSUB(b.x)], 1u);
        const unsigned gen = old / nloc;
        if (old + 1u == (gen + 1u) * nloc) {
            __builtin_amdgcn_fence(__ATOMIC_RELEASE, "agent");
            asm volatile("s_waitcnt vmcnt(0)" ::: "memory");
            const unsigned og = xb_add(&bar[XB_TOP], 1u);
            const unsigned tg = og / nx;
            if (og + 1u == (tg + 1u) * nx) xb_add(&bar[XB_TOPGEN], 1u);
            else XB_SPIN(xb_ld(&bar[XB_TOPGEN]) == tg, bar);
            __builtin_amdgcn_fence(__ATOMIC_ACQUIRE, "agent");
            xb_add(&bar[XB_XGEN(b.x)], 1u);
            asm volatile("s_waitcnt vmcnt(0)" ::: "memory");
        } else {
            XB_SPIN(xb_ld(&bar[XB_XGEN(b.x)]) == gen, bar);
            __builtin_amdgcn_fence(__ATOMIC_ACQUIRE, "agent");
            asm volatile("s_waitcnt vmcnt(0)" ::: "memory");
        }
    }
    __syncthreads();
}

constexpr int RING_BYTES = 131072;
constexpr int LDS_BYTES = 147456;
constexpr int MISC_OFF = LDS_BYTES - 128;
constexpr int NWAVES = 8;

struct Frame { LAS unsigned char* lds; int tid, lane, wave, G, vcu; P p; };

__device__ __forceinline__ void p0_item(const float* W, int ldw, h16* WT, int ldt, int drow0, int k0, int n0, LAS float* scr, int lane, const float* gk = nullptr) {
#pragma unroll 8
    for (int i = 0; i < 32; ++i) { const int kk = 2 * i + (lane >> 5); scr[kk * 33 + (lane & 31)] = W[(size_t)(k0 + kk) * ldw + n0 + (lane & 31)]; }
    asm volatile("s_waitcnt lgkmcnt(0)" ::: "memory");
    const int c = lane & 7;
    f32x4 g0 = {1.f, 1.f, 1.f, 1.f}, g1 = {1.f, 1.f, 1.f, 1.f};
    if (gk) { g0 = *(const f32x4*)(gk + k0 + 8 * c); g1 = *(const f32x4*)(gk + k0 + 8 * c + 4); }
#pragma unroll
    for (int j = 0; j < 4; ++j) { const int n = (lane >> 3) + 8 * j; const LAS float* s = scr + (8 * c) * 33 + n;
        u32x4 o; o.x = pkh(s[0 * 33] * g0.x, s[1 * 33] * g0.y); o.y = pkh(s[2 * 33] * g0.z, s[3 * 33] * g0.w); o.z = pkh(s[4 * 33] * g1.x, s[5 * 33] * g1.y); o.w = pkh(s[6 * 33] * g1.z, s[7 * 33] * g1.w);
        *(u32x4*)(WT + (size_t)(drow0 + n) * ldt + k0 + 8 * c) = o; }
    asm volatile("s_waitcnt lgkmcnt(0)" ::: "memory");
}
__device__ __forceinline__ void raw_row_h16(const float* xrow, h16* orow, float* rstd_out, int lane) {
    const f32x4* xr = (const f32x4*)xrow + lane; f32x4 v[4]; float s = 0.f;
#pragma unroll
    for (int j = 0; j < 4; ++j) { v[j] = xr[64 * j]; s += (v[j].x * v[j].x + v[j].y * v[j].y) + (v[j].z * v[j].z + v[j].w * v[j].w); }
    const float r = rsqrtf(wave_sum(s) * (1.f / D) + EPS);
    u32x2* o8 = (u32x2*)orow + lane;
#pragma unroll
    for (int j = 0; j < 4; ++j) { u32x2 w; w.x = pkh(v[j].x, v[j].y); w.y = pkh(v[j].z, v[j].w); o8[64 * j] = w; }
    if (lane == 0) *rstd_out = r;
}
__device__ __forceinline__ void p0_prologue(Frame& F) {
    const P& p = F.p; unsigned char* ws = p.ws;
    LAS float* scr = (LAS float*)(F.lds + F.wave * 16384);
    const int gw = F.vcu * NWAVES + F.wave, NGW = F.G * NWAVES;
    constexpr int I_IN = 16 * 160, I_UA = 8 * 32, I_OUT = 16 * 32, I_PLE = 4 * 32, I_E13 = 16 * 16, I_E2 = 8 * 32;
    constexpr int NITEMS = I_IN + 2 * I_UA + 2 * I_OUT + I_PLE + NE * (2 * I_E13 + I_E2);
    for (int it = gw; it < NITEMS; it += NGW) {
        int r = it;
        if (r < I_IN) { const int kb = r / 160, nb = r % 160; p0_item(p.w_in, INC, (h16*)(ws + WS_WIN), D, nb * 32, kb * 64, nb * 32, scr, F.lane, p.g_mix); continue; } r -= I_IN;
        if (r < I_UA) { const int kb = r / 32, nb = r % 32; p0_item(p.w_up_a, D, (h16*)(ws + WS_WUA), 512, nb * 32, kb * 64, nb * 32, scr, F.lane); continue; } r -= I_UA;
        if (r < I_UA) { const int kb = r / 32, nb = r % 32; p0_item(p.w_up_b, D, (h16*)(ws + WS_WUB), 512, nb * 32, kb * 64, nb * 32, scr, F.lane); continue; } r -= I_UA;
        if (r < I_OUT) { const int kb = r / 32, nb = r % 32; p0_item(p.w_out, D, (h16*)(ws + WS_WOUT), D, nb * 32, kb * 64, nb * 32, scr, F.lane); continue; } r -= I_OUT;
        if (r < I_OUT) { const int kb = r / 32, nb = r % 32; p0_item(p.w_pg, D, (h16*)(ws + WS_WPG), D, nb * 32, kb * 64, nb * 32, scr, F.lane, p.g_ple); continue; } r -= I_OUT;
        if (r < I_PLE) { const int kb = r / 32, nb = r % 32; p0_item(p.w_ple, D, (h16*)(ws + WS_WPLE), PLE, nb * 32, kb * 64, nb * 32, scr, F.lane); continue; } r -= I_PLE;
        const int e = r / (2 * I_E13 + I_E2); r -= e * (2 * I_E13 + I_E2);
        if (r < 2 * I_E13) { const int which = r / I_E13; r -= which * I_E13; const int kb = r / 16, nb = r % 16, n0 = nb * 32;
            const int drow = (n0 >> 7) * 256 + which * 128 + (n0 & 127);
            p0_item((which ? p.w3 : p.w1) + (size_t)e * D * DE, DE, (h16*)(ws + WS_W13) + (size_t)e * D * D, D, drow, kb * 64, n0, scr, F.lane, p.g_ffn); continue; }
        r -= 2 * I_E13;
        { const int kb = r / 32, nb = r % 32; p0_item(p.w2 + (size_t)e * DE * D, D, (h16*)(ws + WS_W2) + (size_t)e * D * DE, DE, nb * 32, kb * 64, nb * 32, scr, F.lane); }
    }
    const int gt = F.vcu * 512 + F.tid, NGT = F.G * 512;
    for (int i = gt; i < 48 * 1024; i += NGT) { const int n = i >> 10, k = i & 1023; float v = 0.f;
        if (n < 4) v = p.w_grp[k * 4 + n] * p.g_ffn[k]; else if (n < 36) v = p.w_exp[k * 32 + (n - 4)] * p.g_ffn[k];
        ((h16*)(ws + WS_WR))[i] = (h16)v; }
    for (int i = gt; i < 8 * 128 * 128; i += NGT) { const int t = (i >> 7) & 127, s = i & 127; ((h16*)(ws + WS_WSP))[i] = (h16)(s <= t ? p.gm_w_sp[i] : 0.f); }
    for (int i = gt; i < 512; i += NGT) ((float*)(ws + WS_LB))[i] = 1.f / (1.f + expf(p.hg_lb[512 + i] - p.hg_lb[i]));
    for (int m = gw; m < T; m += NGW) raw_row_h16(p.x + (size_t)m * D, (h16*)(ws + WS_HB) + (size_t)m * D, (float*)(ws + WS_RSTD) + m, F.lane);
}

struct PhIn {
    static constexpr int KT = 16, LDA = 2048, LDB = 2048; static constexpr bool PERM = true, GATHER = false;
    using Unit = g8::Tile;
    g8::StaticOrder S; unsigned char* ws; int noepi;
    __device__ __forceinline__ bool next(int i, Unit& u) const { return S.next(i, u); }
    __device__ __forceinline__ const char* a_ptr(const Unit& u) const { return (const char*)(ws + WS_HB) + (size_t)u.pm * 256 * LDA; }
    __device__ __forceinline__ const char* b_ptr(const Unit& u) const { return (const char*)(ws + WS_WIN) + (size_t)u.pn * 256 * LDB; }
    __device__ __forceinline__ void a_off(const Unit&, const int (&)[2], const int (&)[2], unsigned (&)[2][2]) const {}
    template <int MODE> __device__ __forceinline__ void store_tile(const f32x4 (&acc)[2][2][4][2], h16* base, int ld, int row0, int col0, int lbc0) const {
        f32x4 l0[2], l1[2]; float rs[2][4];
#pragma unroll
        for (int ai = 0; ai < 2; ++ai)
#pragma unroll
            for (int m = 0; m < 4; ++m) rs[ai][m] = ((const float*)(ws + WS_RSTD))[row0 + ai * 128 + m * 16];
        if (MODE == 2) {
#pragma unroll
            for (int bj = 0; bj < 2; ++bj) { l0[bj] = *(const f32x4*)((const float*)(ws + WS_LB) + lbc0 + bj * 128); l1[bj] = *(const f32x4*)((const float*)(ws + WS_LB) + lbc0 + bj * 128 + 4); }
        }
#pragma unroll
        for (int ai = 0; ai < 2; ++ai)
#pragma unroll
            for (int m = 0; m < 4; ++m) { h16* rowp = base + (size_t)(row0 + ai * 128 + m * 16) * ld + col0;
#pragma unroll
                for (int bj = 0; bj < 2; ++bj) { f32x4 v0 = acc[ai][bj][m][0] * rs[ai][m], v1 = acc[ai][bj][m][1] * rs[ai][m];
#pragma unroll
                    for (int j = 0; j < 4; ++j) {
                        if (MODE == 0) { v0[j] = fgelu(v0[j]); v1[j] = fgelu(v1[j]); }
                        if (MODE == 1) { v0[j] = v0[j] * fsig(v0[j]); v1[j] = v1[j] * fsig(v1[j]); }
                        if (MODE == 2) { const float a = l0[bj][j], b = l1[bj][j];
                            v0[j] = 0.6931471805599453f * __builtin_amdgcn_logf(a + (1.f - a) * fsig(v0[j])); v1[j] = 0.6931471805599453f * __builtin_amdgcn_logf(b + (1.f - b) * fsig(v1[j])); }
                        if (MODE == 4) { v0[j] = fsig(v0[j]); v1[j] = fsig(v1[j]); }
                    }
                    *(u32x4*)(rowp + bj * 128) = pk8(v0, v1); } }
    }
    __device__ __forceinline__ bool epi(const f32x4 (&acc)[2][2][4][2], const Unit& u, int wr, int wc, int fr, int fq) const {
        if (noepi) {
#pragma unroll
            for (int a = 0; a < 2; ++a)
#pragma unroll
                for (int b = 0; b < 2; ++b)
#pragma unroll
                    for (int m = 0; m < 4; ++m) asm volatile("" :: "v"(acc[a][b][m][0]), "v"(acc[a][b][m][1]));
            return false; }
        const int pn = u.pn, row0 = u.pm * 256 + wr * 64 + fr, cl = wc * 32 + 8 * fq;
        if (pn < 12) { h16* base = (h16*)(ws + WS_UB + (size_t)(pn >> 1) * 32 * MiB); const int col0 = (pn & 1) * 256 + cl;
            if (pn < 4) store_tile<0>(acc, base, 512, row0, col0, 0);
            else if (pn < 6) store_tile<1>(acc, base, 512, row0, col0, 0);
            else if (pn < 8) store_tile<2>(acc, base, 512, row0, col0, col0);
            else store_tile<3>(acc, base, 512, row0, col0, 0);
        } else { h16* base = (h16*)(ws + (pn < 16 ? WS_GA : WS_GB)); store_tile<4>(acc, base, 1024, row0, ((pn - 12) & 3) * 256 + cl, 0); }
        return false;
    }
};

constexpr int WRS = 2064;
constexpr int RT_SCR = 100352;
__device__ __forceinline__ void route_phase(Frame& F) {
    const P& p = F.p; unsigned char* ws = p.ws; const int lane = F.lane, fr = lane & 15, fq = lane >> 4;
    for (int i = F.tid; i < 48 * 128; i += 512) { const int n = i >> 7, c = i & 127; *(LAS u32x4*)(F.lds + n * WRS + c * 16) = *(const u32x4*)(ws + WS_WR + (size_t)n * 2048 + c * 16); }
    LAS float* scr = (LAS float*)(F.lds + RT_SCR + F.wave * 3200);
    LAS int* hist = (LAS int*)(F.lds + RT_SCR + 8 * 3200);
    for (int tile = F.vcu * 8 + F.wave; tile < T / 16; tile += F.G * 8) {
        if (F.tid < 64) hist[F.tid] = 0;
        __syncthreads();
        const int row = tile * 16 + fr;
        const h16* xr = (const h16*)(ws + WS_HB) + (size_t)row * D + fq * 8;
        float ss = 0.f; f32x4 acc[3] = {{0.f, 0.f, 0.f, 0.f}, {0.f, 0.f, 0.f, 0.f}, {0.f, 0.f, 0.f, 0.f}};
#pragma unroll 8
        for (int ks = 0; ks < 32; ++ks) {
            const h16x8 af = *(const h16x8*)(xr + ks * 32);
#pragma unroll
            for (int j = 0; j < 8; ++j) { const float v = (float)af[j]; ss += v * v; }
#pragma unroll
            for (int nt = 0; nt < 3; ++nt) { const h16x8 bf = *(const LAS h16x8*)(F.lds + (16 * nt + fr) * WRS + ks * 64 + fq * 16);
                acc[nt] = __builtin_amdgcn_mfma_f32_16x16x32_f16(af, bf, acc[nt], 0, 0, 0); }
        }
        ss += __shfl_xor(ss, 16); ss += __shfl_xor(ss, 32);
        const float rstd = rsqrtf(ss * (1.f / D) + EPS);
#pragma unroll
        for (int nt = 0; nt < 3; ++nt)
#pragma unroll
            for (int r = 0; r < 4; ++r) scr[(4 * fq + r) * 48 + 16 * nt + fr] = acc[nt][r];
        if (lane < 16) { scr[16 * 48 + lane] = rstd; ((float*)(ws + WS_RSTD))[row] = rstd; }
        asm volatile("s_waitcnt lgkmcnt(0)" ::: "memory");
        int E0 = 0, E1 = 0, p0 = 0, p1 = 0; float g0 = 0.f, g1 = 0.f;
        if (lane < 16) {
            const float rs = scr[16 * 48 + lane]; const LAS float* lg = scr + lane * 48;
            int gs = 0; float best = lg[0];
#pragma unroll
            for (int n = 1; n < 4; ++n) { const float v = lg[n]; if (v > best) { best = v; gs = n; } }
            float den = 0.f;
#pragma unroll
            for (int n = 0; n < 4; ++n) den += expf((lg[n] - best) * rs);
            const float pg = 1.f / den;
            const LAS float* le = lg + 4 + gs * 8;
            int e0 = 0; float l0 = le[0];
#pragma unroll
            for (int n = 1; n < 8; ++n) { const float v = le[n]; if (v > l0) { l0 = v; e0 = n; } }
            int e1 = -1; float l1 = -3.0e38f;
#pragma unroll
            for (int n = 0; n < 8; ++n) { const float v = le[n]; if (n != e0 && v > l1) { l1 = v; e1 = n; } }
            const float w1 = expf((l1 - l0) * rs);
            g0 = pg / (1.f + w1); g1 = pg * w1 / (1.f + w1);
            E0 = gs * 8 + e0; E1 = gs * 8 + e1;
            p0 = atomicAdd((int*)hist + E0, 1); p1 = atomicAdd((int*)hist + E1, 1);
        }
        __syncthreads();
        if (F.tid < 32) { const int c = hist[F.tid]; hist[32 + F.tid] = c ? atomicAdd((int*)(ws + WS_CNT) + F.tid, c) : 0; }
        __syncthreads();
        if (lane < 16) { int* list = (int*)(ws + WS_LIST); float* gate = (float*)(ws + WS_GATE);
            list[(size_t)E0 * ECAP + hist[32 + E0] + p0] = 2 * row; gate[2 * row] = g0;
            list[(size_t)E1 * ECAP + hist[32 + E1] + p1] = 2 * row + 1; gate[2 * row + 1] = g1; }
        __syncthreads();
    }
    for (size_t i = ((size_t)F.vcu * 512 + F.tid) * 4; i < (size_t)T * PLE; i += (size_t)F.G * 512 * 4) { const f32x4 v = *(const f32x4*)(p.p + i); u32x2 w; w.x = pkh(v.x, v.y); w.y = pkh(v.z, v.w); *(u32x2*)((h16*)(ws + WS_P16) + i) = w; }
}

struct UnitMoe { int e, rt, pn, cnt; };
struct MoeOrder {
    int cnt[4], nt[4], j, x;
    __device__ void init(const int* gcnt, int bx) { x = bx & 7; j = bx >> 3;
#pragma unroll
        for (int q = 0; q < 4; ++q) { cnt[q] = gcnt[x + 8 * q]; nt[q] = (cnt[q] + 255) >> 8; } }
    __device__ bool next(int i, UnitMoe& u) const {
        int q = i * 32 + j;
#pragma unroll
        for (int k = 0; k < 4; ++k) { const int nu = nt[k] * 4; if (q < nu) { u.e = x + 8 * k; u.rt = q >> 2; u.pn = q & 3; u.cnt = cnt[k]; return true; } q -= nu; }
        return false;
    }
};
struct PhMup {
    static constexpr int KT = 16, LDA = 2048, LDB = 2048; static constexpr bool PERM = true, GATHER = true;
    using Unit = UnitMoe;
    MoeOrder S; unsigned char* ws;
    __device__ __forceinline__ bool next(int i, Unit& u) const { return S.next(i, u); }
    __device__ __forceinline__ const char* a_ptr(const Unit&) const { return (const char*)(ws + WS_HB); }
    __device__ __forceinline__ const char* b_ptr(const Unit& u) const { return (const char*)(ws + WS_W13) + ((size_t)u.e * 1024 + (size_t)u.pn * 256) * LDB; }
    __device__ __forceinline__ void a_off(const Unit& u, const int (&R)[2], const int (&C)[2], unsigned (&o)[2][2]) const {
        const int* list = (const int*)(ws + WS_LIST) + (size_t)u.e * ECAP;
#pragma unroll
        for (int h = 0; h < 2; ++h)
#pragma unroll
            for (int i = 0; i < 2; ++i) { int r = u.rt * 256 + h * 128 + R[i]; r = r < u.cnt ? r : u.cnt - 1; o[h][i] = (unsigned)((list[r] >> 1) * LDA + C[i] * 2); }
    }
    __device__ __forceinline__ bool epi(const f32x4 (&acc)[2][2][4][2], const Unit& u, int wr, int wc, int fr, int fq) const {
        const int* list = (const int*)(ws + WS_LIST) + (size_t)u.e * ECAP; h16* H = (h16*)(ws + WS_H);
        const int col0 = u.pn * 128 + wc * 32 + 8 * fq;
#pragma unroll
        for (int ai = 0; ai < 2; ++ai)
#pragma unroll
            for (int m = 0; m < 4; ++m) { const int r = u.rt * 256 + ai * 128 + wr * 64 + m * 16 + fr;
                if (r < u.cnt) { const int a = list[r]; const float rs = ((const float*)(ws + WS_RSTD))[a >> 1]; f32x4 v0 = acc[ai][0][m][0] * rs, v1 = acc[ai][0][m][1] * rs;
#pragma unroll
                    for (int j = 0; j < 4; ++j) { v0[j] = v0[j] * fsig(v0[j]) * (acc[ai][1][m][0][j] * rs); v1[j] = v1[j] * fsig(v1[j]) * (acc[ai][1][m][1][j] * rs); }
                    *(u32x4*)(H + (size_t)a * DE + col0) = pk8(v0, v1); } }
        return false;
    }
};
struct PhMdn {
    static constexpr int KT = 8, LDA = 1024, LDB = 1024; static constexpr bool PERM = true, GATHER = true;
    using Unit = UnitMoe;
    MoeOrder S; unsigned char* ws;
    __device__ __forceinline__ bool next(int i, Unit& u) const { return S.next(i, u); }
    __device__ __forceinline__ const char* a_ptr(const Unit&) const { return (const char*)(ws + WS_H); }
    __device__ __forceinline__ const char* b_ptr(const Unit& u) const { return (const char*)(ws + WS_W2) + ((size_t)u.e * 1024 + (size_t)u.pn * 256) * LDB; }
    __device__ __forceinline__ void a_off(const Unit& u, const int (&R)[2], const int (&C)[2], unsigned (&o)[2][2]) const {
        const int* list = (const int*)(ws + WS_LIST) + (size_t)u.e * ECAP;
#pragma unroll
        for (int h = 0; h < 2; ++h)
#pragma unroll
            for (int i = 0; i < 2; ++i) { int r = u.rt * 256 + h * 128 + R[i]; r = r < u.cnt ? r : u.cnt - 1; o[h][i] = (unsigned)(list[r] * LDA + C[i] * 2); }
    }
    __device__ __forceinline__ bool epi(const f32x4 (&acc)[2][2][4][2], const Unit& u, int wr, int wc, int fr, int fq) const {
        const int* list = (const int*)(ws + WS_LIST) + (size_t)u.e * ECAP; h16* Y = (h16*)(ws + WS_Y); const float* gate = (const float*)(ws + WS_GATE);
        const int col0 = u.pn * 256 + wc * 32 + 8 * fq;
#pragma unroll
        for (int ai = 0; ai < 2; ++ai)
#pragma unroll
            for (int m = 0; m < 4; ++m) { const int r = u.rt * 256 + ai * 128 + wr * 64 + m * 16 + fr;
                if (r < u.cnt) { const int a = list[r]; const float g = gate[a];
#pragma unroll
                    for (int bj = 0; bj < 2; ++bj) *(u32x4*)(Y + (size_t)a * D + col0 + bj * 128) = pk8(acc[ai][bj][m][0] * g, acc[ai][bj][m][1] * g); } }
        return false;
    }
};
__device__ __forceinline__ void combine_phase(Frame& F) {
    const P& p = F.p; unsigned char* ws = p.ws; const int lane = F.lane;
    for (int m = F.vcu * NWAVES + F.wave; m < T; m += F.G * NWAVES) {
        u32x4* xr = (u32x4*)((h16*)(ws + WS_HB) + (size_t)m * D) + lane; const u32x4* y0 = (const u32x4*)((const h16*)(ws + WS_Y) + (size_t)(2 * m) * D) + lane;
        float s = 0.f;
#pragma unroll
        for (int j = 0; j < 2; ++j) { f32x4 a, b, c0, c1, d0, d1; unpk8(xr[64 * j], a, b); unpk8(y0[64 * j], c0, c1); unpk8(y0[128 + 64 * j], d0, d1);
            a = a + c0 + d0; b = b + c1 + d1; const u32x4 w = pk8(a, b); xr[64 * j] = w; unpk8(w, a, b);
            s += (a.x * a.x + a.y * a.y) + (a.z * a.z + a.w * a.w) + (b.x * b.x + b.y * b.y) + (b.z * b.z + b.w * b.w); }
        const float r = rsqrtf(wave_sum(s) * (1.f / D) + EPS);
        if (lane == 0) ((float*)(ws + WS_RSTD))[m] = r;
    }
}
__device__ __forceinline__ void final_phase(Frame& F) {
    const P& p = F.p; const int lane = F.lane;
    for (int m = F.vcu * NWAVES + F.wave; m < T; m += F.G * NWAVES) {
        f32x4* xr = (f32x4*)(p.out + (size_t)m * D) + lane; f32x4 v[4]; float s = 0.f;
#pragma unroll
        for (int j = 0; j < 4; ++j) { v[j] = xr[64 * j]; s += (v[j].x * v[j].x + v[j].y * v[j].y) + (v[j].z * v[j].z + v[j].w * v[j].w); }
        const float r = rsqrtf(wave_sum(s) * (1.f / D) + EPS);
#pragma unroll
        for (int j = 0; j < 4; ++j) { const f32x4 gg = ((const f32x4*)p.g_final)[lane + 64 * j]; xr[64 * j] = v[j] * gg * r; }
    }
}

typedef short s16x8 __attribute__((ext_vector_type(8)));
typedef __bf16 bf16x2_t __attribute__((ext_vector_type(2)));
__device__ __forceinline__ unsigned cvt_pk_bf16(float lo, float hi) { const f32x2 v = {lo, hi}; const bf16x2_t r = __builtin_convertvector(v, bf16x2_t); return __builtin_bit_cast(unsigned, r); }
__device__ __forceinline__ unsigned lds_addr(LAS unsigned char* p) { return (unsigned)(size_t)p; }
#define TR2(lo, hi, a0, a1) asm volatile("ds_read_b64_tr_b16 %0, %2\n\tds_read_b64_tr_b16 %1, %3" : "=&v"(lo), "=&v"(hi) : "v"(a0), "v"(a1) : "memory")
#define TRFRAG(T, lo, hi) __builtin_bit_cast(T, (u32x4){(lo).x, (lo).y, (hi).x, (hi).y})

constexpr int GM_RS = 1056;
__device__ __forceinline__ void gmlp_phase(Frame& F) {
    const P& p = F.p; unsigned char* ws = p.ws; const int lane = F.lane, w = F.wave, fr = lane & 15, fq = lane >> 4;
    const f32x4 lg0 = *(const f32x4*)(p.gm_ln_g + 8 * lane), lg1 = *(const f32x4*)(p.gm_ln_g + 8 * lane + 4), lb0 = *(const f32x4*)(p.gm_ln_b + 8 * lane), lb1 = *(const f32x4*)(p.gm_ln_b + 8 * lane + 4);
    for (int tile = F.vcu; tile < T / 128; tile += F.G) {
        const size_t t0 = (size_t)tile * 128;
        const h16* vb = (const h16*)(ws + WS_VB); h16* ub = (h16*)(ws + WS_UB);
        { u32x4 raw[16];
#pragma unroll
          for (int i = 0; i < 16; ++i) raw[i] = *(const u32x4*)(vb + (t0 + w + 8 * i) * 512 + 8 * lane);
#pragma unroll
          for (int i = 0; i < 16; ++i) { const int t = w + 8 * i; f32x4 a, b; unpk8(raw[i], a, b);
            const float mean = wave_sum((a.x + a.y) + (a.z + a.w) + (b.x + b.y) + (b.z + b.w)) * (1.f / 512);
            a = a - mean; b = b - mean;
            const float r = rsqrtf(wave_sum((a.x * a.x + a.y * a.y) + (a.z * a.z + a.w * a.w) + (b.x * b.x + b.y * b.y) + (b.z * b.z + b.w * b.w)) * (1.f / 512) + EPS);
            *(LAS u32x4*)(F.lds + t * GM_RS + lane * 16) = pk8(a * r * lg0 + lb0, b * r * lg1 + lb1); } }
        __syncthreads();
        const int g = w; const h16* Wg = (const h16*)(ws + WS_WSP) + (size_t)g * 128 * 128;
        const unsigned trbase = lds_addr(F.lds) + (8 * fq + (fr >> 2)) * GM_RS + g * 128 + (lane & 3) * 8;
#pragma unroll
        for (int half = 0; half < 2; ++half) {
            f32x4 acc[4][4];
#pragma unroll
            for (int a = 0; a < 4; ++a)
#pragma unroll
                for (int c = 0; c < 4; ++c) acc[a][c] = (f32x4){0.f, 0.f, 0.f, 0.f};
            h16x8 wf[4][4];
#pragma unroll
            for (int ks = 0; ks < 4; ++ks)
#pragma unroll
                for (int m4 = 0; m4 < 4; ++m4) { const int mi = 4 * half + m4; if (mi >= 2 * ks) wf[ks][m4] = *(const h16x8*)(Wg + (16 * mi + fr) * 128 + 32 * ks + 8 * fq); }
#pragma unroll
            for (int ks = 0; ks < 4; ++ks) { if (2 * ks > 4 * half + 3) continue;
                u32x2 lo[4], hi[4];
#pragma unroll
                for (int c = 0; c < 4; ++c) TR2(lo[c], hi[c], trbase + (32 * ks) * GM_RS + c * 32, trbase + (32 * ks + 4) * GM_RS + c * 32);
                asm volatile("s_waitcnt lgkmcnt(0)" : "+v"(lo[0]), "+v"(hi[0]), "+v"(lo[1]), "+v"(hi[1]), "+v"(lo[2]), "+v"(hi[2]), "+v"(lo[3]), "+v"(hi[3]) :: "memory");
                __builtin_amdgcn_sched_barrier(0);
#pragma unroll
                for (int c = 0; c < 4; ++c) { const h16x8 vf = TRFRAG(h16x8, lo[c], hi[c]);
#pragma unroll
                    for (int m4 = 0; m4 < 4; ++m4) { const int mi = 4 * half + m4; if (mi >= 2 * ks) acc[m4][c] = __builtin_amdgcn_mfma_f32_16x16x32_f16(vf, wf[ks][m4], acc[m4][c], 0, 0, 0); } }
            }
            u32x2 ur[4][4]; float bias[4];
#pragma unroll
            for (int m4 = 0; m4 < 4; ++m4) { const int t = 16 * (4 * half + m4) + fr; bias[m4] = p.gm_b_sp[g * 128 + t];
#pragma unroll
                for (int c = 0; c < 4; ++c) ur[m4][c] = *(const u32x2*)(ub + (t0 + t) * 512 + g * 64 + 16 * c + 4 * fq); }
#pragma unroll
            for (int m4 = 0; m4 < 4; ++m4) { const int t = 16 * (4 * half + m4) + fr;
#pragma unroll
                for (int c = 0; c < 4; ++c) { h16* up = ub + (t0 + t) * 512 + g * 64 + 16 * c + 4 * fq; const h16x4 uh = __builtin_bit_cast(h16x4, ur[m4][c]); const float bs = bias[m4];
                    u32x2 o; o.x = pkh((float)uh[0] * (acc[m4][c][0] + bs), (float)uh[1] * (acc[m4][c][1] + bs)); o.y = pkh((float)uh[2] * (acc[m4][c][2] + bs), (float)uh[3] * (acc[m4][c][3] + bs));
                    *(u32x2*)up = o; } }
        }
        __syncthreads();
        const f32x4 n0 = *(const f32x4*)(p.hg_norm_g + 8 * lane), n1 = *(const f32x4*)(p.hg_norm_g + 8 * lane + 4);
#pragma unroll
        for (int bt = 0; bt < 2; ++bt) { u32x4 ro[8], rg[8];
#pragma unroll
            for (int i = 0; i < 8; ++i) { const size_t row = t0 + w + 8 * (8 * bt + i); ro[i] = *(const u32x4*)((const h16*)(ws + WS_IB) + row * 512 + 8 * lane); rg[i] = *(const u32x4*)((const h16*)(ws + WS_OB) + row * 512 + 8 * lane); }
#pragma unroll
            for (int i = 0; i < 8; ++i) { const size_t row = t0 + w + 8 * (8 * bt + i); f32x4 a, b, ga, gb; unpk8(ro[i], a, b); unpk8(rg[i], ga, gb);
                float ss = (a.x * a.x + a.y * a.y) + (a.z * a.z + a.w * a.w) + (b.x * b.x + b.y * b.y) + (b.z * b.z + b.w * b.w);
                ss += __shfl_xor(ss, 1); ss += __shfl_xor(ss, 2); ss += __shfl_xor(ss, 4); ss += __shfl_xor(ss, 8);
                const float r = rsqrtf(ss * (1.f / 128) + EPS);
#pragma unroll
                for (int j = 0; j < 4; ++j) { a[j] = a[j] * r * n0[j] * fsig(ga[j]); b[j] = b[j] * r * n1[j] * fsig(gb[j]); }
                *(u32x4*)((h16*)(ws + WS_QB) + row * 512 + 8 * lane) = pk8(a, b); } }
    }
}

constexpr int HQ_RS = 272, HE_RS = 288, HI_RS = 80, HS_RS = 80, HA_RS = 144;
constexpr int HG_QD = 0, HG_KI = 17408, HG_KE = 34816, HG_I = 53248, HG_S = 58368, HG_ATT = 68608, HG_TOT = 77824, HG_DEC = 79872, HG_RQ = 80384, HG_RF = 97792;
__device__ __forceinline__ void hgrn_phase(Frame& F) {
    const P& p = F.p; unsigned char* ws = p.ws; const int tid = F.tid, lane = F.lane, w = F.wave, fr = lane & 15, fq = lane >> 4;
    constexpr float L2E = 1.4426950408889634f;
    LAS unsigned char* L = F.lds; const unsigned LA = lds_addr(L);
    for (int item = F.vcu; item < 256; item += F.G) {
        const int bh = item >> 2, sl = item & 3, b = bh >> 2, h = bh & 3;
        const int k = tid & 127, tq = tid >> 7;
        h16* ib = (h16*)(ws + WS_IB) + (size_t)b * SEQ * 512 + h * 128 + sl * 32;
        const int is = tid >> 3, iv4 = (tid & 7) * 4;
        f32x4 S0 = {0.f, 0.f, 0.f, 0.f}, S1 = {0.f, 0.f, 0.f, 0.f};
        for (int i = tid; i < 128 * HS_RS / 4; i += 512) ((LAS unsigned*)(L + HG_S))[i] = 0u;
        const h16* qg = (const h16*)(ws + WS_QB) + (size_t)b * SEQ * 512 + h * 128; const h16* fg = (const h16*)(ws + WS_FB) + (size_t)b * SEQ * 512 + h * 128;
        const int pt0 = tid >> 4, pk = (tid & 15) * 8;
        u32x4 pq[2], pf[2]; u32x2 ri;
#pragma unroll
        for (int u = 0; u < 2; ++u) { pq[u] = *(const u32x4*)(qg + (size_t)(pt0 + 32 * u) * 512 + pk); pf[u] = *(const u32x4*)(fg + (size_t)(pt0 + 32 * u) * 512 + pk); }
        ri = *(const u32x2*)(ib + (size_t)is * 512 + iv4);
#pragma unroll
        for (int u = 0; u < 2; ++u) { *(LAS u32x4*)(L + HG_RQ + (pt0 + 32 * u) * HQ_RS + pk * 2) = pq[u]; *(LAS u32x4*)(L + HG_RF + (pt0 + 32 * u) * HQ_RS + pk * 2) = pf[u]; }
        __syncthreads();
        h16x8 Lf[4][2];
#pragma unroll
        for (int mi = 0; mi < 4; ++mi)
#pragma unroll
            for (int ks = 0; ks < 2; ++ks)
#pragma unroll
                for (int j = 0; j < 8; ++j) Lf[mi][ks][j] = (32 * ks + 8 * fq + j <= 16 * mi + fr) ? (h16)1.0f : (h16)0.0f;
        for (int c = 0; c < SEQ / 64; ++c) {
            const h16x4 ih = __builtin_bit_cast(h16x4, ri);
            if (c + 1 < SEQ / 64) {
#pragma unroll
                for (int u = 0; u < 2; ++u) { pq[u] = *(const u32x4*)(qg + ((size_t)(c + 1) * 64 + pt0 + 32 * u) * 512 + pk); pf[u] = *(const u32x4*)(fg + ((size_t)(c + 1) * 64 + pt0 + 32 * u) * 512 + pk); }
                ri = *(const u32x2*)(ib + ((size_t)(c + 1) * 64 + is) * 512 + iv4);
            }
            f32x4 bb[4];
            { u32x2 fl[2], fh[2];
#pragma unroll
              for (int ks = 0; ks < 2; ++ks) TR2(fl[ks], fh[ks], LA + HG_RF + (32 * ks + (8 * fq + (fr >> 2))) * HQ_RS + w * 32 + (lane & 3) * 8, LA + HG_RF + (32 * ks + 4 + (8 * fq + (fr >> 2))) * HQ_RS + w * 32 + (lane & 3) * 8);
              asm volatile("s_waitcnt lgkmcnt(0)" : "+v"(fl[0]), "+v"(fh[0]), "+v"(fl[1]), "+v"(fh[1]) :: "memory");
              __builtin_amdgcn_sched_barrier(0);
#pragma unroll
              for (int mi = 0; mi < 4; ++mi) { bb[mi] = (f32x4){0.f, 0.f, 0.f, 0.f};
#pragma unroll
                  for (int ks = 0; ks < 2; ++ks) if (2 * ks <= mi) bb[mi] = __builtin_amdgcn_mfma_f32_16x16x32_f16(TRFRAG(h16x8, fl[ks], fh[ks]), Lf[mi][ks], bb[mi], 0, 0, 0); } }
            f32x4 EL;
#pragma unroll
            for (int r = 0; r < 4; ++r) EL[r] = __builtin_amdgcn_exp2f(__shfl(bb[3][r], (lane & 48) | 15) * L2E);
            if (fr == 0) *(LAS f32x4*)(L + HG_DEC + (16 * w + 4 * fq) * 4) = EL;
#pragma unroll
            for (int mi = 0; mi < 4; ++mi) { const int t = 16 * mi + fr; const int kb = (16 * w + 4 * fq) * 2;
                const u32x2 rq2 = *(const LAS u32x2*)(L + HG_RQ + t * HQ_RS + kb), rf2 = *(const LAS u32x2*)(L + HG_RF + t * HQ_RS + kb);
                const h16x4 qh = __builtin_bit_cast(h16x4, rq2), fh4 = __builtin_bit_cast(h16x4, rf2);
                float qd[4], ki[4], ke[4];
#pragma unroll
                for (int r = 0; r < 4; ++r) { const float E = __builtin_amdgcn_exp2f(bb[mi][r] * L2E), rE = __builtin_amdgcn_rcpf(E), kf = 1.f - __builtin_amdgcn_exp2f((float)fh4[r] * L2E);
                    qd[r] = (float)qh[r] * E; ki[r] = kf * rE; ke[r] = ki[r] * EL[r]; }
                u32x2 wq, wi, we; wq.x = cvt_pk_bf16(qd[0], qd[1]); wq.y = cvt_pk_bf16(qd[2], qd[3]); wi.x = cvt_pk_bf16(ki[0], ki[1]); wi.y = cvt_pk_bf16(ki[2], ki[3]); we.x = cvt_pk_bf16(ke[0], ke[1]); we.y = cvt_pk_bf16(ke[2], ke[3]);
                *(LAS u32x2*)(L + HG_QD + t * HQ_RS + kb) = wq; *(LAS u32x2*)(L + HG_KI + t * HQ_RS + kb) = wi; *(LAS u32x2*)(L + HG_KE + t * HE_RS + kb) = we; }
            { u32x2 iw; iw.x = cvt_pk_bf16((float)ih[0], (float)ih[1]); iw.y = cvt_pk_bf16((float)ih[2], (float)ih[3]); *(LAS u32x2*)(L + HG_I + is * HI_RS + iv4 * 2) = iw; }
            __syncthreads();
            { const int mi = w >> 1;
#pragma unroll
              for (int nn = 0; nn < 2; ++nn) { const int ni = 2 * (w & 1) + nn; f32x4 at = {0.f, 0.f, 0.f, 0.f};
                if (ni <= mi) {
#pragma unroll
                    for (int ks = 0; ks < 4; ++ks) { const s16x8 qf = *(const LAS s16x8*)(L + HG_QD + (16 * mi + fr) * HQ_RS + 64 * ks + 16 * fq), kf = *(const LAS s16x8*)(L + HG_KI + (16 * ni + fr) * HQ_RS + 64 * ks + 16 * fq);
                        at = __builtin_amdgcn_mfma_f32_16x16x32_bf16(kf, qf, at, 0, 0, 0); }
#pragma unroll
                    for (int r = 0; r < 4; ++r) at[r] = (16 * mi + fr >= 16 * ni + 4 * fq + r) ? at[r] : 0.f;
                }
                u32x2 aw; aw.x = cvt_pk_bf16(at[0], at[1]); aw.y = cvt_pk_bf16(at[2], at[3]);
                *(LAS u32x2*)(L + HG_ATT + (16 * mi + fr) * HA_RS + (16 * ni + 4 * fq) * 2) = aw; } }
            __syncthreads();
            if (c + 1 < SEQ / 64) {
#pragma unroll
                for (int u = 0; u < 2; ++u) { *(LAS u32x4*)(L + HG_RQ + (pt0 + 32 * u) * HQ_RS + pk * 2) = pq[u]; *(LAS u32x4*)(L + HG_RF + (pt0 + 32 * u) * HQ_RS + pk * 2) = pf[u]; } }
            { const int mi = w >> 1, vi = w & 1;
              const unsigned trq = (8 * fq + (fr >> 2)), trp = (lane & 3) * 8;
              u32x2 il[2][2], ih2[2][2], sl_[4], sh_[4], kl[2], kh[2];
#pragma unroll
              for (int ks = 0; ks < 2; ++ks)
#pragma unroll
                  for (int vb = 0; vb < 2; ++vb) TR2(il[ks][vb], ih2[ks][vb], LA + HG_I + (32 * ks + trq) * HI_RS + vb * 32 + trp, LA + HG_I + (32 * ks + 4 + trq) * HI_RS + vb * 32 + trp);
#pragma unroll
              for (int ks = 0; ks < 4; ++ks) TR2(sl_[ks], sh_[ks], LA + HG_S + (32 * ks + trq) * HS_RS + vi * 32 + trp, LA + HG_S + (32 * ks + 4 + trq) * HS_RS + vi * 32 + trp);
#pragma unroll
              for (int ks = 0; ks < 2; ++ks) TR2(kl[ks], kh[ks], LA + HG_KE + (32 * ks + trq) * HE_RS + w * 32 + trp, LA + HG_KE + (32 * ks + 4 + trq) * HE_RS + w * 32 + trp);
              asm volatile("s_waitcnt lgkmcnt(0)" : "+v"(il[0][0]), "+v"(ih2[0][0]), "+v"(il[0][1]), "+v"(ih2[0][1]), "+v"(il[1][0]), "+v"(ih2[1][0]), "+v"(il[1][1]), "+v"(ih2[1][1]) :: "memory");
              asm volatile("" : "+v"(sl_[0]), "+v"(sh_[0]), "+v"(sl_[1]), "+v"(sh_[1]), "+v"(sl_[2]), "+v"(sh_[2]), "+v"(sl_[3]), "+v"(sh_[3]), "+v"(kl[0]), "+v"(kh[0]), "+v"(kl[1]), "+v"(kh[1]) :: "memory");
              __builtin_amdgcn_sched_barrier(0);
              f32x4 o = {0.f, 0.f, 0.f, 0.f};
#pragma unroll
              for (int ks = 0; ks < 2; ++ks) { const s16x8 ar = *(const LAS s16x8*)(L + HG_ATT + (16 * mi + fr) * HA_RS + 64 * ks + 16 * fq);
                  o = __builtin_amdgcn_mfma_f32_16x16x32_bf16(TRFRAG(s16x8, il[ks][vi], ih2[ks][vi]), ar, o, 0, 0, 0); }
#pragma unroll
              for (int ks = 0; ks < 4; ++ks) { const s16x8 qr = *(const LAS s16x8*)(L + HG_QD + (16 * mi + fr) * HQ_RS + 64 * ks + 16 * fq);
                  o = __builtin_amdgcn_mfma_f32_16x16x32_bf16(TRFRAG(s16x8, sl_[ks], sh_[ks]), qr, o, 0, 0, 0); }
              { u32x2 ow; ow.x = pkh(o[0], o[1]); ow.y = pkh(o[2], o[3]); *(u32x2*)(ib + ((size_t)c * 64 + 16 * mi + fr) * 512 + 16 * vi + 4 * fq) = ow; }
              const f32x4 dc = *(const LAS f32x4*)(L + HG_DEC + (16 * w + 4 * fq) * 4);
              S0 = S0 * dc; S1 = S1 * dc;
#pragma unroll
              for (int ks = 0; ks < 2; ++ks) { const s16x8 kf = TRFRAG(s16x8, kl[ks], kh[ks]);
                  S0 = __builtin_amdgcn_mfma_f32_16x16x32_bf16(kf, TRFRAG(s16x8, il[ks][0], ih2[ks][0]), S0, 0, 0, 0);
                  S1 = __builtin_amdgcn_mfma_f32_16x16x32_bf16(kf, TRFRAG(s16x8, il[ks][1], ih2[ks][1]), S1, 0, 0, 0); } }
            __syncthreads();
#pragma unroll
            for (int r = 0; r < 4; r += 2) { const unsigned a0 = cvt_pk_bf16(S0[r], S0[r + 1]), a1 = cvt_pk_bf16(S1[r], S1[r + 1]); const int kk = 16 * w + 4 * fq + r;
                *(LAS unsigned short*)(L + HG_S + kk * HS_RS + fr * 2) = (unsigned short)(a0 & 0xffffu); *(LAS unsigned short*)(L + HG_S + (kk + 1) * HS_RS + fr * 2) = (unsigned short)(a0 >> 16);
                *(LAS unsigned short*)(L + HG_S + kk * HS_RS + (16 + fr) * 2) = (unsigned short)(a1 & 0xffffu); *(LAS unsigned short*)(L + HG_S + (kk + 1) * HS_RS + (16 + fr) * 2) = (unsigned short)(a1 >> 16); }
        }
        __syncthreads();
    }
}

struct UnitUp { int pm, pn, half; };
struct PhUp {
    static constexpr int KT = 8, LDA = 1024, LDB = 1024; static constexpr bool PERM = true, GATHER = false;
    using Unit = UnitUp;
    g8::StaticOrder S; unsigned char* ws;
    __device__ __forceinline__ bool next(int i, Unit& u) const { g8::Tile t; if (!S.next(i >> 1, t)) return false; u.pm = t.pm; u.pn = t.pn; u.half = i & 1; return true; }
    __device__ __forceinline__ const char* a_ptr(const Unit& u) const { return (const char*)(ws + (u.half ? WS_QB : WS_UB)) + (size_t)u.pm * 256 * LDA; }
    __device__ __forceinline__ const char* b_ptr(const Unit& u) const { return (const char*)(ws + (u.half ? WS_WUB : WS_WUA)) + (size_t)u.pn * 256 * LDB; }
    __device__ __forceinline__ void a_off(const Unit&, const int (&)[2], const int (&)[2], unsigned (&)[2][2]) const {}
    __device__ __forceinline__ bool epi(f32x4 (&acc)[2][2][4][2], const Unit& u, int wr, int wc, int fr, int fq) const {
        const int row0 = u.pm * 256 + wr * 64 + fr, col0 = u.pn * 256 + wc * 32 + 8 * fq;
        h16* ga = (h16*)(ws + WS_GA); const h16* gb = (const h16*)(ws + WS_GB);
#pragma unroll
        for (int ai = 0; ai < 2; ++ai)
#pragma unroll
            for (int m = 0; m < 4; ++m) { const size_t off = (size_t)(row0 + ai * 128 + m * 16) * D + col0;
#pragma unroll
                for (int bj = 0; bj < 2; ++bj) { f32x4 b0, b1; unpk8(*(const u32x4*)(gb + off + bj * 128), b0, b1);
#pragma unroll
                    for (int j = 0; j < 4; ++j) { b0[j] = fmaxf(b0[j], 6.2e-5f); b1[j] = fmaxf(b1[j], 6.2e-5f); }
                    if (u.half == 0) { f32x4 a0, a1; unpk8(*(const u32x4*)(ga + off + bj * 128), a0, a1);
#pragma unroll
                        for (int j = 0; j < 4; ++j) { acc[ai][bj][m][0][j] *= a0[j] * __builtin_amdgcn_rcpf(b0[j]); acc[ai][bj][m][1][j] *= a1[j] * __builtin_amdgcn_rcpf(b1[j]); }
                    } else { *(u32x4*)(ga + off + bj * 128) = pk8(acc[ai][bj][m][0] * b0, acc[ai][bj][m][1] * b1); } }
                if (m & 1) asm volatile("" ::: "memory"); }
        return u.half == 0;
    }
};
struct PhOut {
    static constexpr int KT = 16, LDA = 2048, LDB = 2048; static constexpr bool PERM = true, GATHER = false;
    using Unit = g8::Tile;
    g8::StaticOrder S; unsigned char* ws; const float* x; float* out;
    __device__ __forceinline__ bool next(int i, Unit& u) const { return S.next(i, u); }
    __device__ __forceinline__ const char* a_ptr(const Unit& u) const { return (const char*)(ws + WS_GA) + (size_t)u.pm * 256 * LDA; }
    __device__ __forceinline__ const char* b_ptr(const Unit& u) const { return (const char*)(ws + WS_WOUT) + (size_t)u.pn * 256 * LDB; }
    __device__ __forceinline__ void a_off(const Unit&, const int (&)[2], const int (&)[2], unsigned (&)[2][2]) const {}
    __device__ __forceinline__ bool epi(const f32x4 (&acc)[2][2][4][2], const Unit& u, int wr, int wc, int fr, int fq) const {
        const int row0 = u.pm * 256 + wr * 64 + fr, col0 = u.pn * 256 + wc * 32 + 8 * fq; h16* hb = (h16*)(ws + WS_HB);
#pragma unroll
        for (int ai = 0; ai < 2; ++ai)
#pragma unroll
            for (int m = 0; m < 4; ++m) { const size_t off = (size_t)(row0 + ai * 128 + m * 16) * D + col0;
#pragma unroll
                for (int bj = 0; bj < 2; ++bj) { f32x4 x0, x1; unpk8(*(const u32x4*)(hb + off + bj * 128), x0, x1);
                    *(u32x4*)(hb + off + bj * 128) = pk8(x0 + acc[ai][bj][m][0], x1 + acc[ai][bj][m][1]); }
                if (m & 1) asm volatile("" ::: "memory"); }
        return false;
    }
};
struct PhPle {
    static constexpr int KT = 4, LDA = 512, LDB = 512; static constexpr bool PERM = true, GATHER = false;
    using Unit = g8::Tile;
    g8::StaticOrder S; unsigned char* ws;
    __device__ __forceinline__ bool next(int i, Unit& u) const { return S.next(i, u); }
    __device__ __forceinline__ const char* a_ptr(const Unit& u) const { return (const char*)(ws + WS_P16) + (size_t)u.pm * 256 * LDA; }
    __device__ __forceinline__ const char* b_ptr(const Unit& u) const { return (const char*)(ws + WS_WPLE) + (size_t)u.pn * 256 * LDB; }
    __device__ __forceinline__ void a_off(const Unit&, const int (&)[2], const int (&)[2], unsigned (&)[2][2]) const {}
    __device__ __forceinline__ bool epi(const f32x4 (&acc)[2][2][4][2], const Unit& u, int wr, int wc, int fr, int fq) const {
        const int row0 = u.pm * 256 + wr * 64 + fr, col0 = u.pn * 256 + wc * 32 + 8 * fq; h16* pl = (h16*)(ws + WS_PL);
#pragma unroll
        for (int ai = 0; ai < 2; ++ai)
#pragma unroll
            for (int m = 0; m < 4; ++m) { const size_t off = (size_t)(row0 + ai * 128 + m * 16) * D + col0;
#pragma unroll
                for (int bj = 0; bj < 2; ++bj) *(u32x4*)(pl + off + bj * 128) = pk8(acc[ai][bj][m][0], acc[ai][bj][m][1]); }
        return false;
    }
};
struct PhPg {
    static constexpr int KT = 16, LDA = 2048, LDB = 2048; static constexpr bool PERM = true, GATHER = false;
    using Unit = g8::Tile;
    g8::StaticOrder S; unsigned char* ws; float* out;
    __device__ __forceinline__ bool next(int i, Unit& u) const { return S.next(i, u); }
    __device__ __forceinline__ const char* a_ptr(const Unit& u) const { return (const char*)(ws + WS_HB) + (size_t)u.pm * 256 * LDA; }
    __device__ __forceinline__ const char* b_ptr(const Unit& u) const { return (const char*)(ws + WS_WPG) + (size_t)u.pn * 256 * LDB; }
    __device__ __forceinline__ void a_off(const Unit&, const int (&)[2], const int (&)[2], unsigned (&)[2][2]) const {}
    __device__ __forceinline__ bool epi(const f32x4 (&acc)[2][2][4][2], const Unit& u, int wr, int wc, int fr, int fq) const {
        const int row0 = u.pm * 256 + wr * 64 + fr, col0 = u.pn * 256 + wc * 32 + 8 * fq; const h16* pl = (const h16*)(ws + WS_PL); const h16* hb = (const h16*)(ws + WS_HB);
#pragma unroll
        for (int ai = 0; ai < 2; ++ai)
#pragma unroll
            for (int m = 0; m < 4; ++m) { const size_t off = (size_t)(row0 + ai * 128 + m * 16) * D + col0; const float rs = ((const float*)(ws + WS_RSTD))[row0 + ai * 128 + m * 16];
#pragma unroll
                for (int bj = 0; bj < 2; ++bj) { f32x4 p0, p1, x0, x1; unpk8(*(const u32x4*)(pl + off + bj * 128), p0, p1); unpk8(*(const u32x4*)(hb + off + bj * 128), x0, x1);
#pragma unroll
                    for (int j = 0; j < 4; ++j) { x0[j] += fsig(acc[ai][bj][m][0][j] * rs) * p0[j]; x1[j] += fsig(acc[ai][bj][m][1][j] * rs) * p1[j]; }
                    *(f32x4*)(out + off + bj * 128) = x0; *(f32x4*)(out + off + bj * 128 + 4) = x1; }
                asm volatile("" ::: "memory"); }
        return false;
    }
};

struct Args { P p; int ph_lo, ph_hi, use_bar, pad; };
__global__ void __launch_bounds__(512, 2) mega(Args a) {
    extern __shared__ __attribute__((aligned(16))) unsigned char lds_raw[];
    Frame F; F.lds = (LAS unsigned char*)lds_raw; F.tid = threadIdx.x; F.lane = F.tid & 63; F.wave = __builtin_amdgcn_readfirstlane(F.tid >> 6);
    F.G = gridDim.x; { const int bx = blockIdx.x; F.vcu = (F.G % 8 == 0) ? (bx % 8) * (F.G / 8) + bx / 8 : bx; }
    F.p = a.p;
    volatile LAS unsigned* MISC = (volatile LAS unsigned*)(F.lds + MISC_OFF);
    if (F.tid < 32) MISC[F.tid] = 0u;
    __syncthreads();
    XcdBarrier bar; bar.bar = (unsigned*)(a.p.ws + WS_CTL); bar.x = 0; bar.st = nullptr;
    if (a.use_bar) bar = xcd_barrier_post((unsigned*)(a.p.ws + WS_CTL), MISC + 8);
    const int lo = a.ph_lo, hi = a.ph_hi;
#define IN(k) (lo <= (k) && (k) < hi)
#define SEAM(k) do { if (IN(k) && IN((k) + 1)) xcd_barrier(bar); } while (0)
    unsigned char* ws = a.p.ws;
    if (IN(0)) { if (blockIdx.x == 0 && F.tid < 32) ((int*)(ws + WS_CNT))[F.tid] = 0; p0_prologue(F); } SEAM(0);
    if (IN(1)) {
#ifndef STAGGER1
#define STAGGER1 0
#endif
        if (STAGGER1 > 0 && ((blockIdx.x >> 3) & 1)) { const unsigned long long t0 = __builtin_amdgcn_s_memrealtime(); while (__builtin_amdgcn_s_memrealtime() - t0 < (unsigned long long)STAGGER1) __builtin_amdgcn_s_sleep(32); }
        PhIn ph; ph.S.init(T / 256, INC / 256, F.G, (int)blockIdx.x); ph.ws = ws; ph.noepi = a.pad; g8::gemm_phase(F.lds, ph); } SEAM(1);
    if (IN(2)) { hgrn_phase(F); } SEAM(2);
    if (IN(3)) { gmlp_phase(F); } SEAM(3);
    if (IN(4)) { PhUp ph; ph.S.init(T / 256, D / 256, F.G, (int)blockIdx.x); ph.ws = ws; g8::gemm_phase(F.lds, ph); } SEAM(4);
    if (IN(5)) { PhOut ph; ph.S.init(T / 256, D / 256, F.G, (int)blockIdx.x); ph.ws = ws; ph.x = a.p.x; ph.out = a.p.out; g8::gemm_phase(F.lds, ph); } SEAM(5);
    if (IN(6)) { route_phase(F); } SEAM(6);
    if (IN(7)) { PhMup ph; ph.S.init((const int*)(ws + WS_CNT), (int)blockIdx.x); ph.ws = ws; g8::gemm_phase(F.lds, ph); } SEAM(7);
    if (IN(8)) { PhMdn ph; ph.S.init((const int*)(ws + WS_CNT), (int)blockIdx.x); ph.ws = ws; g8::gemm_phase(F.lds, ph); } SEAM(8);
    if (IN(9)) { combine_phase(F); } SEAM(9);
    if (IN(10)) {
#ifndef SUB10
#define SUB10 3
#endif
        if (SUB10 & 1) { PhPle ph; ph.S.init(T / 256, D / 256, F.G, (int)blockIdx.x); ph.ws = ws; g8::gemm_phase(F.lds, ph); }
        if (SUB10 & 2) { PhPg ph; ph.S.init(T / 256, D / 256, F.G, (int)blockIdx.x); ph.ws = ws; ph.out = a.p.out; g8::gemm_phase(F.lds, ph); }
    } SEAM(10);
    if (IN(11)) { final_phase(F); }
#undef IN
#undef SEAM
}

__global__ void n_p16(P p) { size_t i = ((size_t)blockIdx.x * 256 + threadIdx.x) * 4; f32x4 v = *(const f32x4*)(p.p + i); u32x2 w; w.x = pkh(v.x, v.y); w.y = pkh(v.z, v.w); *(u32x2*)((h16*)(p.ws + WS_P16) + i) = w; }

static void launch_mega(const P& p, int lo, int hi, int use_bar, hipStream_t stream, int flags = 0) {
    Args a{}; a.p = p; a.ph_lo = lo; a.ph_hi = hi; a.use_bar = use_bar; a.pad = flags;
    hipLaunchKernelGGL(mega, dim3(256), dim3(512), LDS_BYTES, stream, a);
}

extern "C" void kernel_launch(void* const* d_in, const int* in_sizes, int n_in, void* d_out, int out_size, void* d_ws, size_t ws_size, hipStream_t stream) {
    static int ready = 0;
    if (!ready) {
        if (n_in != 23 || ws_size < WS_END) { fprintf(stderr, "kernel_launch: unexpected n_in %d / ws_size %zu\n", n_in, ws_size); ready = -1; return; }
        if (hipFuncSetAttribute((const void*)mega, hipFuncAttributeMaxDynamicSharedMemorySize, LDS_BYTES) != hipSuccess) { fprintf(stderr, "kernel_launch: hipFuncSetAttribute failed\n"); ready = -1; return; }
        ready = 1;
    }
    if (ready < 0) return;
    P p{};
    const float** f = (const float**)&p;
    for (int i = 0; i < 23; ++i) f[i] = (const float*)d_in[i];
    p.out = (float*)d_out; p.ws = (unsigned char*)d_ws;
    (void)hipMemsetAsync((char*)d_ws + WS_CNT, 0, 4096 + XCD_BAR_WORDS * 4, stream);
#ifdef OPTMASK
    launch_mega(p, 0, 1, 0, stream);
    if (OPTMASK & 2) launch_mega(p, 1, 2, 0, stream);
    else { n_rmsnorm<<<T / 4, 256, 0, stream>>>(p.x, p.g_mix, (h16*)(p.ws + WS_HB)); ngemm<0, F_in><<<dim3(INC / 64, T / 64), 256, 0, stream>>>(INC, D, F_in{p}); }
    if (OPTMASK & 4) launch_mega(p, 2, 3, 0, stream); else n_hgrn<<<64, 128, 0, stream>>>(p);
    if (OPTMASK & 8) launch_mega(p, 3, 4, 0, stream); else { n_lnv<<<T / 4, 256, 0, stream>>>(p); n_gmlp<<<dim3(T / 128, 8), 256, 0, stream>>>(p); n_hgfin<<<T / 4, 256, 0, stream>>>(p); }
    if (OPTMASK & 16) launch_mega(p, 4, 5, 0, stream); else ngemm<1, F_up><<<dim3(D / 64, T / 64), 256, 0, stream>>>(D, 512, F_up{p});
    if (OPTMASK & 32) launch_mega(p, 5, 6, 0, stream); else ngemm<0, F_out><<<dim3(D / 64, T / 64), 256, 0, stream>>>(D, D, F_out{p});
    if (OPTMASK & 64) launch_mega(p, 6, 7, 0, stream); else n_route<<<T / 4, 256, 0, stream>>>(p);
    if (OPTMASK & 128) launch_mega(p, 7, 8, 0, stream); else ngemm<1, F_mup><<<dim3(DE / 64, ECAP / 64, NE), 256, 0, stream>>>(DE, D, F_mup{p});
    if (OPTMASK & 256) launch_mega(p, 8, 9, 0, stream); else ngemm<0, F_mdn><<<dim3(D / 64, ECAP / 64, NE), 256, 0, stream>>>(D, DE, F_mdn{p});
    if (OPTMASK & 512) launch_mega(p, 9, 10, 0, stream); else n_combine<<<T / 4, 256, 0, stream>>>(p);
    if (OPTMASK & 1024) { if (!(OPTMASK & 64)) n_p16<<<T * PLE / 1024, 256, 0, stream>>>(p);
        if (!(SUB10 & 1)) ngemm<0, F_ple><<<dim3(D / 64, T / 64), 256, 0, stream>>>(D, PLE, F_ple{p});
        launch_mega(p, 10, 11, 0, stream);
        if (!(SUB10 & 2)) ngemm<0, F_pg><<<dim3(D / 64, T / 64), 256, 0, stream>>>(D, D, F_pg{p}); }
    else { ngemm<0, F_ple><<<dim3(D / 64, T / 64), 256, 0, stream>>>(D, PLE, F_ple{p}); ngemm<0, F_pg><<<dim3(D / 64, T / 64), 256, 0, stream>>>(D, D, F_pg{p}); }
    if (OPTMASK & 2048) launch_mega(p, 11, 12, 0, stream); else n_final<<<T / 4, 256, 0, stream>>>(p);
#else
#ifdef PROBE_REP
#ifndef PROBE_FLAGS
#define PROBE_FLAGS 0
#endif
    launch_mega(p, 0, PROBE_REP + 1, 1, stream, PROBE_FLAGS);
    (void)hipMemsetAsync((char*)d_ws + WS_CNT, 0, 4096 + XCD_BAR_WORDS * 4, stream);
#endif
    launch_mega(p, 0, 12, 1, stream);
#endif
}
```
